# Optimizing an MI355X kernel written in HIP

```python
import math
import jax, jax.numpy as jnp
from jax import lax
import numpy as np

D_MODEL = 1024
BATCH = 2
SEQ = 8192
DEPTH = 1

EPS = 1e-6
D_SSM = D_MODEL // 2
SSM_GROUP = 16
N_SSM_GROUPS = D_SSM // SSM_GROUP
SSM_STATE = 64
DT_MIN = 1e-3
DT_MAX = 1e-1
HEAD_DIM = 64
N_HEADS = (D_MODEL // 2) // HEAD_DIM
N_KV_HEADS = 2
Q_PER_KV = N_HEADS // N_KV_HEADS
D_ATTN = N_HEADS * HEAD_DIM
WINDOW = 128
BLOCK = 128
N_BRANCHES = 2
Q_COLS = D_ATTN
KV_COLS = N_KV_HEADS * HEAD_DIM
GATE_COLS = N_BRANCHES * D_MODEL
IN_COLS = Q_COLS + 2 * KV_COLS + D_SSM + GATE_COLS
N_EXPERT_GROUPS = 4
EXPERTS_PER_GROUP = 8
N_EXPERTS = N_EXPERT_GROUPS * EXPERTS_PER_GROUP
TOP_K = 2
D_FF_EXPERT = D_MODEL // 2

kernel_name = "hybrid_s5_swa_sink_hmoe_block"


def rmsnorm(x, g):
    xf = x.astype(jnp.float32)
    inv = lax.rsqrt(jnp.mean(xf * xf, axis=-1, keepdims=True) + EPS)
    return (xf * inv * g.astype(jnp.float32)).astype(x.dtype)


def sliding_window_attention(q, k, v, sinks):
    b, l = q.shape[0], q.shape[1]
    nb = l // BLOCK
    qb = q.reshape(b, nb, BLOCK, N_KV_HEADS, Q_PER_KV, HEAD_DIM)

    def band(t):
        tb = t.reshape(b, nb, BLOCK, N_KV_HEADS, HEAD_DIM)
        prev = jnp.pad(tb[:, :-1], ((0, 0), (1, 0), (0, 0), (0, 0), (0, 0)))
        return jnp.concatenate([prev, tb], axis=2)

    kb, vb = band(k), band(v)
    scale = 1.0 / math.sqrt(HEAD_DIM)
    s = jnp.einsum('bnqkgd,bnskd->bnkgqs', qb, kb,
                   preferred_element_type=jnp.float32) * scale
    blk = jnp.arange(nb)[:, None, None] * BLOCK
    qpos = blk + jnp.arange(BLOCK)[None, :, None]
    kpos = blk - BLOCK + jnp.arange(2 * BLOCK)[None, None, :]
    rel = qpos - kpos
    mask = (rel >= 0) & (rel < WINDOW) & (kpos >= 0)
    s = jnp.where(mask[None, :, None, None], s, jnp.finfo(jnp.float32).min)
    sink = sinks.astype(jnp.float32).reshape(1, 1, N_KV_HEADS, Q_PER_KV, 1, 1)
    m = jnp.maximum(jnp.max(s, axis=-1, keepdims=True), sink)
    p = jnp.exp(s - m)
    denom = jnp.sum(p, axis=-1, keepdims=True) + jnp.exp(sink - m)
    p = (p / denom).astype(v.dtype)
    o = jnp.einsum('bnkgqs,bnskd->bnqkgd', p, vb)
    return o.reshape(b, l, D_ATTN)


def s5_ssm(u, a_re, a_im, b_re, b_im, c_re, c_im, d_skip, log_dt):
    b, l = u.shape[0], u.shape[1]
    f32 = jnp.float32
    uf = u.astype(f32).reshape(b, l, N_SSM_GROUPS, SSM_GROUP)
    lam = lax.complex(a_re.astype(f32), a_im.astype(f32))
    dt = jnp.exp(log_dt.astype(f32))[:, None]
    lam_bar = jnp.exp(lam * dt)
    b_mat = lax.complex(b_re.astype(f32), b_im.astype(f32))
    b_bar = ((lam_bar - 1.0) / lam)[:, :, None] * b_mat
    bu = jnp.einsum('blgc,gpc->blgp', uf.astype(jnp.complex64), b_bar)
    a = jnp.broadcast_to(lam_bar, bu.shape)

    def combine(left, right):
        a_l, b_l = left
        a_r, b_r = right
        return a_l * a_r, a_r * b_l + b_r

    _, states = lax.associative_scan(combine, (a, bu), axis=1)
    c_mat = lax.complex(c_re.astype(f32), c_im.astype(f32))
    y = jnp.real(jnp.einsum('blgp,gcp->blgc', states, c_mat))
    y = y + d_skip.astype(f32).reshape(N_SSM_GROUPS, SSM_GROUP) * uf
    return y.reshape(b, l, D_SSM)


def hierarchical_moe(h, w_rg, b_rg, w_re, b_re, w_gate, w_up, w_down):
    b, l, d = h.shape
    n_tok = b * l
    t = h.reshape(n_tok, d)
    group_logits = (t @ w_rg).astype(jnp.float32) + b_rg.astype(jnp.float32)
    group_probs = jax.nn.softmax(group_logits, axis=-1)
    group_p, group_idx = lax.top_k(group_probs, 1)
    expert_logits = ((t @ w_re).astype(jnp.float32) + b_re.astype(jnp.float32)
                     ).reshape(n_tok, N_EXPERT_GROUPS, EXPERTS_PER_GROUP)
    sel_logits = jnp.take_along_axis(expert_logits, group_idx[:, :, None], axis=1)[:, 0]
    within = jax.nn.softmax(sel_logits, axis=-1)
    w_top, e_local = lax.top_k(within, TOP_K)
    w_top = w_top / jnp.sum(w_top, axis=-1, keepdims=True) * group_p
    expert_ids = group_idx * EXPERTS_PER_GROUP + e_local
    flat_e = expert_ids.reshape(-1)
    order = jnp.argsort(flat_e)
    tok = order // TOP_K
    xs = t[tok]
    sizes = jnp.bincount(flat_e, length=N_EXPERTS).astype(jnp.int32)
    hg = lax.ragged_dot(xs, w_gate, sizes)
    hu = lax.ragged_dot(xs, w_up, sizes)
    ys = lax.ragged_dot(jax.nn.silu(hg) * hu, w_down, sizes)
    ws = w_top.reshape(-1)[order].astype(ys.dtype)
    out = jax.ops.segment_sum(ys * ws[:, None], tok, num_segments=n_tok)
    return out.reshape(b, l, d).astype(h.dtype)


def setup_inputs(seed: int = 0) -> dict:
    key = jax.random.key(seed)
    ks = jax.random.split(key, 32)
    f32 = jnp.float32
    L, D = DEPTH, D_MODEL
    G, P, C = N_SSM_GROUPS, SSM_STATE, SSM_GROUP

    def nrm(k, shape, scale):
        return jax.random.normal(k, shape, f32) * scale

    n_idx = jnp.arange(P, dtype=f32)
    a_re = -0.5 + 0.01 * jax.random.normal(ks[4], (L, G, P), f32)
    a_im = math.pi * n_idx[None, None, :] + 0.01 * jax.random.normal(ks[5], (L, G, P), f32)
    log_dt = jax.random.uniform(ks[12], (L, G), f32, math.log(DT_MIN), math.log(DT_MAX))
    return {
        "x": nrm(ks[0], (BATCH, SEQ, D), 1.0),
        "norm_mix": 1.0 + nrm(ks[1], (L, D), 0.02),
        "w_in": nrm(ks[2], (L, D, IN_COLS), D ** -0.5),
        "b_gate": nrm(ks[3], (L, GATE_COLS), 0.01),
        "attn_sinks": nrm(ks[13], (L, N_HEADS), 1.0),
        "ssm_a_re": a_re,
        "ssm_a_im": a_im,
        "ssm_b_re": nrm(ks[6], (L, G, P, C), (2 * C) ** -0.5),
        "ssm_b_im": nrm(ks[7], (L, G, P, C), (2 * C) ** -0.5),
        "ssm_c_re": nrm(ks[8], (L, G, C, P), (2 * P) ** -0.5),
        "ssm_c_im": nrm(ks[9], (L, G, C, P), (2 * P) ** -0.5),
        "ssm_d": nrm(ks[10], (L, D_SSM), 1.0),
        "ssm_log_dt": log_dt,
        "w_glu": nrm(ks[11], (L, D_SSM, D_SSM), D_SSM ** -0.5),
        "b_glu": nrm(ks[14], (L, D_SSM), 0.01),
        "w_attn_branch": nrm(ks[15], (L, D_ATTN, D), D_ATTN ** -0.5),
        "w_ssm_branch": nrm(ks[16], (L, D_SSM, D), D_SSM ** -0.5),
        "w_out": nrm(ks[17], (L, D, D), D ** -0.5),
        "norm_moe": 1.0 + nrm(ks[18], (L, D), 0.02),
        "w_router_group": nrm(ks[19], (L, D, N_EXPERT_GROUPS), D ** -0.5),
        "b_router_group": nrm(ks[20], (L, N_EXPERT_GROUPS), 0.01),
        "w_router_expert": nrm(ks[21], (L, D, N_EXPERTS), D ** -0.5),
        "b_router_expert": nrm(ks[22], (L, N_EXPERTS), 0.01),
        "w_expert_gate": nrm(ks[23], (L, N_EXPERTS, D, D_FF_EXPERT), D ** -0.5),
        "w_expert_up": nrm(ks[24], (L, N_EXPERTS, D, D_FF_EXPERT), D ** -0.5),
        "w_expert_down": nrm(ks[25], (L, N_EXPERTS, D_FF_EXPERT, D), D_FF_EXPERT ** -0.5),
        "norm_final": 1.0 + nrm(ks[26], (D,), 0.02),
    }


def reference(x, norm_mix, w_in, b_gate, attn_sinks, ssm_a_re, ssm_a_im, ssm_b_re, ssm_b_im,
              ssm_c_re, ssm_c_im, ssm_d, ssm_log_dt, w_glu, b_glu, w_attn_branch, w_ssm_branch,
              w_out, norm_moe, w_router_group, b_router_group, w_router_expert, b_router_expert,
              w_expert_gate, w_expert_up, w_expert_down, norm_final):
    b, l, _ = x.shape
    splits = [Q_COLS, Q_COLS + KV_COLS, Q_COLS + 2 * KV_COLS, Q_COLS + 2 * KV_COLS + D_SSM]
    for i in range(DEPTH):
        h = rmsnorm(x, norm_mix[i])
        proj = h @ w_in[i]
        q, k, v, u, gate_logits = jnp.split(proj, splits, axis=-1)
        q = q.reshape(b, l, N_HEADS, HEAD_DIM)
        k = k.reshape(b, l, N_KV_HEADS, HEAD_DIM)
        v = v.reshape(b, l, N_KV_HEADS, HEAD_DIM)
        attn = sliding_window_attention(q, k, v, attn_sinks[i])
        y = s5_ssm(u, ssm_a_re[i], ssm_a_im[i], ssm_b_re[i], ssm_b_im[i],
                   ssm_c_re[i], ssm_c_im[i], ssm_d[i], ssm_log_dt[i]).astype(x.dtype)
        z = jax.nn.gelu(y)
        z = z * jax.nn.sigmoid(z @ w_glu[i] + b_glu[i])
        gates = jax.nn.sigmoid(gate_logits.astype(jnp.float32) + b_gate[i].astype(jnp.float32))
        g_attn, g_ssm = jnp.split(gates.astype(x.dtype), 2, axis=-1)
        merged = g_attn * (attn @ w_attn_branch[i]) + g_ssm * (z @ w_ssm_branch[i])
        x = x + merged @ w_out[i]
        h2 = rmsnorm(x, norm_moe[i])
        x = x + hierarchical_moe(h2, w_router_group[i], b_router_group[i], w_router_expert[i],
                                 b_router_expert[i], w_expert_gate[i], w_expert_up[i],
                                 w_expert_down[i])
    return rmsnorm(x, norm_final)
```

```cpp
#include <hip/hip_runtime.h>
#include <cstdio>
#include <cstdint>

constexpr int BATCH = 2, SEQ = 8192, D = 1024, M = BATCH * SEQ;
constexpr int DSSM = 512, NG = 32, GC = 16, PS = 64;
constexpr int HD = 64, NH = 8, NKV = 2, DATT = 512, WIN = 128;
constexpr int INC = 3328, GATEC = 2048;
constexpr int NEG = 4, EPG = 8, NE = 32, DFF = 512;
constexpr int QKVU_LD = 1280;
constexpr int QOFF = 0, KOFF = 512, VOFF = 640, UOFF = 768;
constexpr float EPS = 1e-6f;
constexpr int LSUB = 128;
constexpr int NSUB = SEQ / LSUB;

constexpr size_t MiB = 1u << 20;
constexpr size_t WS_CTL = 0, CTL_ZERO_BYTES = 1 * MiB;
constexpr size_t WS_PAR = 1 * MiB;
constexpr size_t WS_SSE = 2 * MiB;
constexpr size_t WS_LIST = 4 * MiB;
constexpr size_t WS_TOK = 253 * MiB;
constexpr size_t WS_WIN = 8 * MiB;
constexpr size_t WS_WGLU = 15 * MiB;
constexpr size_t WS_WA = 16 * MiB;
constexpr size_t WS_WS = 17 * MiB;
constexpr size_t WS_WOUT = 18 * MiB;
constexpr size_t WS_WGU = 20 * MiB;
constexpr size_t WS_WD = 84 * MiB;
constexpr size_t WS_R1 = 116 * MiB;
constexpr size_t WS_GATES = 149 * MiB;
constexpr size_t WS_QKVU = 213 * MiB;
constexpr size_t WS_END = 254 * MiB;
constexpr size_t DO_ATTN = 0, DO_Z = 16 * MiB, DO_ZG = 32 * MiB;

constexpr int CW_TMO = 0;
constexpr int CW_CNT = 1024;
constexpr int CW_BAR = 4096;
constexpr int CW_ROWSS = 16384;

constexpr size_t PAR_LAMB = 0;
constexpr size_t PAR_LAML = 16384;
constexpr size_t PAR_BBAR = 32768;
constexpr size_t PAR_BBT = PAR_BBAR + 32 * 64 * 16 * 8;
constexpr size_t PAR_CMT = PAR_BBT + 32 * 4 * 64 * 16;
constexpr size_t PAR_END = PAR_CMT + 32 * 4 * 64 * 16;
constexpr size_t PAR_RWH = PAR_END;
constexpr size_t PAR_RWL = PAR_RWH + 48 * 1024 * 2;
constexpr size_t PAR_END2 = PAR_RWL + 48 * 1024 * 2;
static_assert(PAR_END2 <= MiB, "PAR region");

constexpr size_t TOK_E = 0;
constexpr size_t TOK_SLOT = 128 * 1024;
constexpr size_t TOK_W = 256 * 1024;
constexpr size_t TOK_INV = 384 * 1024;

constexpr int NWAVES = 8;
constexpr int NTHREADS = NWAVES * 64;
constexpr int LDS_BYTES = 147456;
constexpr int LDS_MISC = 131072;
constexpr int LDS_TILETAB = LDS_MISC + 640;
constexpr int LDS_ROWTAB = LDS_MISC + 2048;
constexpr int LDS_BARW = LDS_MISC + 512;
constexpr int NPH = 11;
#ifndef CV_STREAM_J
#define CV_STREAM_J 22
#endif
#ifndef CV_NGW
#define CV_NGW 208
#endif
#ifndef CV_TAIL_J
#define CV_TAIL_J 0
#endif
#ifndef CV_P8X
#define CV_P8X 8192
#endif
#ifndef CV_P0X
#define CV_P0X 9088
#endif
#ifndef FAST_P1
#define FAST_P1 1
#endif
#ifndef FAST_P4
#define FAST_P4 1
#endif
#ifndef FAST_P5
#define FAST_P5 1
#endif
#ifndef FAST_P6
#define FAST_P6 1
#endif
#ifndef FAST_P0
#define FAST_P0 1
#endif
#ifndef FAST_P10
#define FAST_P10 1
#endif
#ifndef FAST_ATT
#define FAST_ATT 1
#endif
#ifndef FAST_P7
#define FAST_P7 1
#endif
#ifndef FAST_S5
#define FAST_S5 1
#endif
#ifndef FAST_MOE
#define FAST_MOE 1
#endif
#ifndef MK_N_LAUNCHES
#define MK_N_LAUNCHES 1
#endif

typedef unsigned short bf16;
typedef float f32x4 __attribute__((ext_vector_type(4)));
typedef unsigned u32x4 __attribute__((ext_vector_type(4)));


typedef short kbf16x8 __attribute__((ext_vector_type(8)));
__device__ __forceinline__ void mfma_keep(kbf16x8 a, kbf16x8 b, float r0) {
    const u32x4 au = __builtin_bit_cast(u32x4, a), bu = __builtin_bit_cast(u32x4, b);
    asm volatile("" :: "v"(au.x), "v"(au.y), "v"(au.z), "v"(au.w), "v"(bu.x), "v"(bu.y), "v"(bu.z), "v"(bu.w), "v"(r0));
}
__device__ __forceinline__ float opq(float x) { asm volatile("" : "+v"(x)); return x; }
__device__ __forceinline__ float bf2f(bf16 b) { return __uint_as_float(((unsigned)b) << 16); }
__device__ __forceinline__ bf16 f2bf(float f) { unsigned u = __float_as_uint(f); return (bf16)((u + 0x7fffu + ((u >> 16) & 1u)) >> 16); }
__device__ __forceinline__ float wave_sum(float v) {
#pragma unroll
    for (int o = 1; o < 64; o <<= 1) v += __shfl_xor(v, o);
    return v;
}
__device__ __forceinline__ float wave_max(float v) {
#pragma unroll
    for (int o = 1; o < 64; o <<= 1) v = fmaxf(v, __shfl_xor(v, o));
    return v;
}
__device__ __forceinline__ float dot8(u32x4 a, u32x4 b) {
    float s = 0.f;
#pragma unroll
    for (int j = 0; j < 4; ++j) {
        s += __uint_as_float(a[j] << 16) * __uint_as_float(b[j] << 16);
        s += __uint_as_float(a[j] & 0xffff0000u) * __uint_as_float(b[j] & 0xffff0000u);
    }
    return s;
}
__device__ __forceinline__ float sigmoidf_(float x) { return 1.f / (1.f + __expf(-x)); }
__device__ __forceinline__ float gelu_tanh(float x) {
    const float u = 0.7978845608028654f * (x + 0.044715f * x * x * x);
    const float e = __expf(2.f * u);
    const float th = 1.f - 2.f / (e + 1.f);
    return 0.5f * x * (1.f + th);
}

__device__ __forceinline__ double dexp_(double x) {
    const double k = rint(x * 1.4426950408889634);
    const double r = fma(-k, 1.9082149292705877e-10, fma(-k, 0.6931471803691238, x));
    double p = 1.0 / 6227020800.0;
    p = fma(p, r, 1.0 / 479001600.0); p = fma(p, r, 1.0 / 39916800.0); p = fma(p, r, 1.0 / 3628800.0); p = fma(p, r, 1.0 / 362880.0);
    p = fma(p, r, 1.0 / 40320.0); p = fma(p, r, 1.0 / 5040.0); p = fma(p, r, 1.0 / 720.0); p = fma(p, r, 1.0 / 120.0);
    p = fma(p, r, 1.0 / 24.0); p = fma(p, r, 1.0 / 6.0); p = fma(p, r, 0.5); p = fma(p, r, 1.0); p = fma(p, r, 1.0);
    const long long e = (long long)k + 1023;
    return p * __longlong_as_double(e << 52);
}
__device__ __forceinline__ void dsincos_(double x, double& s, double& c) {
    const double k = rint(x * 0.6366197723675814);
    const double r = fma(-k, 6.123233995736766e-17, fma(-k, 1.5707963267948966, x));
    const double r2 = r * r;
    double sp = -1.0 / 1307674368000.0;
    sp = fma(sp, r2, 1.0 / 6227020800.0); sp = fma(sp, r2, -1.0 / 39916800.0); sp = fma(sp, r2, 1.0 / 362880.0);
    sp = fma(sp, r2, -1.0 / 5040.0); sp = fma(sp, r2, 1.0 / 120.0); sp = fma(sp, r2, -1.0 / 6.0); sp = fma(sp * r2, r, r);
    double cp = 1.0 / 20922789888000.0;
    cp = fma(cp, r2, -1.0 / 87178291200.0); cp = fma(cp, r2, 1.0 / 479001600.0); cp = fma(cp, r2, -1.0 / 3628800.0);
    cp = fma(cp, r2, 1.0 / 40320.0); cp = fma(cp, r2, -1.0 / 720.0); cp = fma(cp, r2, 1.0 / 24.0); cp = fma(cp, r2, -0.5); cp = fma(cp, r2, 1.0);
    const int q = ((int)k) & 3;
    s = (q == 0) ? sp : (q == 1) ? cp : (q == 2) ? -sp : -cp;
    c = (q == 0) ? cp : (q == 1) ? -sp : (q == 2) ? -cp : sp;
}


#define LAS __attribute__((address_space(3)))
namespace pg8 {
typedef short bf16x8 __attribute__((ext_vector_type(8)));
constexpr int BM = 256, BK = 64, HALF = 128, HTB = HALF * BK * 2, STAGE_BYTES = 8 * HTB, NXCD = 8, WGM = 8;
__device__ __forceinline__ int lds_byte(int r, int c) { const int st = (r >> 4) * 2 + (c >> 5), rr = r & 15, cc = c & 31, ob = rr * 64 + cc * 2; return st * 1024 + (ob ^ (((ob >> 9) & 1) << 5)); }
__device__ __forceinline__ void stage_rc(int b, int& R, int& C) { const int st = b / 1024, sb = b % 1024, swz = sb ^ (((sb >> 9) & 1) << 5); R = (st >> 1) * 16 + swz / 64; C = (st & 1) * 32 + (swz % 64) / 2; }
__device__ __forceinline__ int perm32(int rho) { const int n = rho >> 4, i = rho & 15; return 8 * (i >> 2) + 4 * n + (i & 3); }
typedef float f32x2_t __attribute__((ext_vector_type(2)));
typedef __bf16 bf16x2_t __attribute__((ext_vector_type(2)));
__device__ __forceinline__ unsigned cvt_pk_bf16(float lo, float hi) { const f32x2_t v = {lo, hi}; const bf16x2_t b = __builtin_convertvector(v, bf16x2_t); return __builtin_bit_cast(unsigned, b); }

struct Unit { const char* a; const char* b; int row0, col0, nrows, aux, rt; };

struct StaticOrder {
    int nM, nN, nwg, G, c;
    __device__ void init(int Mr, int N, int G_, int c_) { nM = Mr / BM; nN = N / BM; nwg = nM * nN; G = G_; c = c_; }
    __device__ bool next(int i, int& pm, int& pn) const { return at((long)i * G + c, pm, pn); }
    __device__ bool at(const long L, int& pm, int& pn) const {
        if (L >= nwg) return false;
        int wgid = (int)L; { const int q = nwg / NXCD, r = nwg % NXCD, xcd = wgid % NXCD, off = wgid / NXCD; wgid = (xcd < r ? xcd * (q + 1) : r * (q + 1) + (xcd - r) * q) + off; }
        const int nig = WGM * nN, gid = wgid / nig, fm = gid * WGM, gsz = (nM - fm) < WGM ? (nM - fm) : WGM;
        pm = fm + ((wgid % nig) % gsz); pn = (wgid % nig) / gsz; return true;
    }
};
struct DenseSched {
    StaticOrder so; const char* A; const char* B; size_t astep, bstep;
    int nfull = 1 << 30;
    __device__ bool next(int i, Unit& u) const {
        const long L = (long)i * so.G + so.c; int pm, pn; int half = -1; long Lu = L;
        if (L >= nfull) { const long hl = L - nfull; Lu = nfull + (hl >> 1); half = (int)(hl & 1); }
        if (!so.at(Lu, pm, pn)) return false;
        u.a = A + (size_t)pm * astep; u.b = B + (size_t)pn * bstep; u.row0 = pm * BM; u.col0 = pn * BM; u.nrows = BM; u.aux = 0; u.rt = 0;
        if (half >= 0) { u.nrows = HALF; if (half) { u.a += astep / 2; u.row0 += HALF; } }
        return true; }
};

template <class Epi, class Sched, bool GATHER, bool GATHER_OR_RAGGED = false, bool CARRY_ACC = false>
__device__ __forceinline__ void gemm_phase(LAS unsigned char* lds, const int K, const int lda, const int ldb, const Sched& S, const Epi& E, const LAS int* rowtab) {
    const int tid = threadIdx.x, wid = __builtin_amdgcn_readfirstlane(tid >> 6), lane = tid & 63, wr = wid >> 2, wc = wid & 3, fr = lane & 15, fq = lane >> 4;
    const int nt = K / BK;
    unsigned voffA[2][2], voffB[2];
#pragma unroll
    for (int i = 0; i < 2; ++i) { int R, C; stage_rc(tid * 16 + i * 8192, R, C); const int Rb = Epi::PERM ? ((R & ~31) + perm32(R & 31)) : R;
        voffB[i] = (unsigned)(Rb * ldb + C) * 2u;
        voffA[0][i] = (unsigned)(R * lda + C) * 2u; voffA[1][i] = (unsigned)((R + HALF) * lda + C) * 2u; }
    const size_t kstep = (size_t)(BK * 2);
    const size_t hstepB = (size_t)HALF * ldb * 2;
    const unsigned ldsw = (unsigned)wid * 1024u;
    const int aoff = lds_byte(wr * 64 + fr, fq * 8), boff = lds_byte(wc * 32 + fr, fq * 8);
#define PG8_SA(b, h) (((b) * 2 + (h)) * HTB)
#define PG8_SB(b, h) ((4 + (b) * 2 + (h)) * HTB)
#define PG8_STAGEB(bufoff, gbase) do { _Pragma("unroll") for (int _i = 0; _i < 2; ++_i) \
        __builtin_amdgcn_global_load_lds((const unsigned*)((const char*)(gbase) + voffB[_i]), (LAS unsigned*)(lds + (bufoff) + ldsw + _i * 8192), 16, 0, 0); } while (0)
#define PG8_STAGEA(bufoff, gbase, h) do { _Pragma("unroll") for (int _i = 0; _i < 2; ++_i) \
        __builtin_amdgcn_global_load_lds((const unsigned*)((const char*)(gbase) + voffA[h][_i]), (LAS unsigned*)(lds + (bufoff) + ldsw + _i * 8192), 16, 0, 0); } while (0)
#define PG8_LDA(dst, b, h) do { _Pragma("unroll") for (int m = 0; m < 4; ++m) _Pragma("unroll") for (int k = 0; k < 2; ++k) dst[m][k] = *(const LAS bf16x8*)(lds + PG8_SA(b, h) + aoff + m * 2048 + k * 1024); } while (0)
#define PG8_LDB(dst, b, h) do { _Pragma("unroll") for (int n = 0; n < 2; ++n) _Pragma("unroll") for (int k = 0; k < 2; ++k) dst[n][k] = *(const LAS bf16x8*)(lds + PG8_SB(b, h) + boff + n * 2048 + k * 1024); } while (0)
#define PG8_MMA(ai, bj, At, Bt) do { __builtin_amdgcn_s_setprio(1); _Pragma("unroll") for (int m = 0; m < 4; ++m) _Pragma("unroll") for (int n = 0; n < 2; ++n) _Pragma("unroll") for (int k = 0; k < 2; ++k) \
        acc[ai][bj][m][n] = __builtin_amdgcn_mfma_f32_16x16x32_bf16(Bt[n][k], At[m][k], acc[ai][bj][m][n], 0, 0, 0); __builtin_amdgcn_s_setprio(0); } while (0)
#define PG8_WAIT_V(n) asm volatile("s_waitcnt vmcnt(" #n ")" ::: "memory")
#define PG8_WAIT_L(n) asm volatile("s_waitcnt lgkmcnt(" #n ")" ::: "memory")
#define PG8_BAR __builtin_amdgcn_s_barrier()
#define PG8_SCHED __builtin_amdgcn_sched_barrier(0)
#define PG8_GATHER_OFFS(uidx) do { if constexpr (GATHER) { _Pragma("unroll") for (int _i = 0; _i < 2; ++_i) { int R, C; stage_rc(tid * 16 + _i * 8192, R, C); \
        voffA[0][_i] = (unsigned)(rowtab[2 * ((uidx) * 256 + R)] * lda + C) * 2u; voffA[1][_i] = (unsigned)(rowtab[2 * ((uidx) * 256 + R + HALF)] * lda + C) * 2u; } } } while (0)
    Unit cur, nxt; int ui = 0;
    if (!S.next(0, cur)) return;
    f32x4 acc[2][2][4][2];
#pragma unroll
    for (int a = 0; a < 2; ++a)
#pragma unroll
        for (int b = 0; b < 2; ++b)
#pragma unroll
            for (int m = 0; m < 4; ++m)
#pragma unroll
                for (int n = 0; n < 2; ++n) acc[a][b][m][n] = (f32x4){0.f, 0.f, 0.f, 0.f};
    bf16x8 At[4][2], B0[2][2], B1[2][2];
    const char* cA = cur.a; const char* cB = cur.b;
    PG8_GATHER_OFFS(0);
    PG8_STAGEB(PG8_SB(0, 0), cB); PG8_STAGEB(PG8_SB(0, 1), cB + hstepB); PG8_STAGEA(PG8_SA(0, 0), cA, 0); PG8_STAGEA(PG8_SA(0, 1), cA, 1);
    if (wr == 1) PG8_BAR;
    PG8_WAIT_V(2); PG8_BAR;
    PG8_STAGEB(PG8_SB(1, 0), cB + kstep); PG8_STAGEA(PG8_SA(1, 0), cA + kstep, 0); PG8_STAGEB(PG8_SB(1, 1), cB + hstepB + kstep);
    PG8_WAIT_V(6); PG8_BAR;
    for (;;) {
        const bool has_next = S.next(ui + 1, nxt);
        const bool skip1 = GATHER_OR_RAGGED && (cur.nrows <= HALF);
        const char* nA = has_next ? nxt.a : cA; const char* nB = has_next ? nxt.b : cB;
        for (int t = 0; t < nt; t += 2) {
            const bool last = (t == nt - 2);
            const char* a1 = cA + (size_t)(t + 1) * kstep;
            const char* a2 = last ? nA : cA + (size_t)(t + 2) * kstep; const char* b2 = last ? nB : cB + (size_t)(t + 2) * kstep;
            const char* a3 = a2 + kstep; const char* b3 = b2 + kstep;
            PG8_LDB(B0, 0, 0); PG8_LDB(B1, 0, 1); PG8_SCHED; PG8_LDA(At, 0, 0); PG8_STAGEA(PG8_SA(1, 1), a1, 1);
            if (GATHER && last && has_next) PG8_GATHER_OFFS(ui + 1);
            PG8_WAIT_V(8); PG8_WAIT_L(0); PG8_BAR; PG8_MMA(0, 0, At, B0); PG8_MMA(0, 1, At, B1); PG8_BAR; PG8_SCHED;
            PG8_LDA(At, 0, 1); PG8_STAGEB(PG8_SB(0, 0), b2); PG8_STAGEB(PG8_SB(0, 1), b2 + hstepB); PG8_STAGEA(PG8_SA(0, 0), a2, 0);
            PG8_WAIT_V(8); PG8_WAIT_L(0); PG8_BAR; if (!skip1) { PG8_MMA(1, 0, At, B0); PG8_MMA(1, 1, At, B1); } PG8_BAR; PG8_SCHED;
            PG8_LDB(B0, 1, 0); PG8_LDB(B1, 1, 1); PG8_SCHED; PG8_LDA(At, 1, 0); PG8_STAGEA(PG8_SA(0, 1), a2, 1);
            PG8_WAIT_V(8); PG8_WAIT_L(0); PG8_BAR; PG8_MMA(0, 0, At, B0); PG8_MMA(0, 1, At, B1); PG8_BAR; PG8_SCHED;
            PG8_LDA(At, 1, 1); PG8_STAGEB(PG8_SB(1, 0), b3); PG8_STAGEB(PG8_SB(1, 1), b3 + hstepB); PG8_STAGEA(PG8_SA(1, 0), a3, 0);
            PG8_WAIT_V(8); PG8_WAIT_L(0); PG8_BAR; if (!skip1) { PG8_MMA(1, 0, At, B0); PG8_MMA(1, 1, At, B1); } PG8_BAR; PG8_SCHED;
        }
        if (wr == 0) PG8_BAR;
        E(acc, cur, ui, wr, wc, fr, fq);
        if (!has_next) break;
        if (!(CARRY_ACC && cur.aux == 1)) {
#pragma unroll
        for (int a = 0; a < 2; ++a)
#pragma unroll
            for (int b = 0; b < 2; ++b)
#pragma unroll
                for (int m = 0; m < 4; ++m)
#pragma unroll
                    for (int n = 0; n < 2; ++n) acc[a][b][m][n] = (f32x4){0.f, 0.f, 0.f, 0.f};
        }
        cur = nxt; cA = nA; cB = nB; ++ui;
        if (wr == 1) PG8_BAR;
    }
    PG8_WAIT_V(0);
    PG8_BAR;
#undef PG8_SA
#undef PG8_SB
#undef PG8_STAGEA
#undef PG8_STAGEB
#undef PG8_LDA
#undef PG8_LDB
#undef PG8_MMA
#undef PG8_WAIT_V
#undef PG8_WAIT_L
#undef PG8_BAR
#undef PG8_SCHED
#undef PG8_GATHER_OFFS
}

__device__ __forceinline__ float sigm(float x) { return __builtin_amdgcn_rcpf(1.f + __builtin_amdgcn_exp2f(-1.4426950408889634f * x)); }
__device__ __forceinline__ f32x4 bflo4(unsigned a, unsigned b) { return (f32x4){__uint_as_float(a << 16), __uint_as_float(a & 0xffff0000u), __uint_as_float(b << 16), __uint_as_float(b & 0xffff0000u)}; }
#define EPI_LOOP_AM _Pragma("unroll") for (int ai = 0; ai < 2; ++ai) _Pragma("unroll") for (int m = 0; m < 4; ++m)
#define EPI_LOOP_AM_H(u) _Pragma("unroll") for (int ai = 0; ai < 2; ++ai) if (ai * HALF < (u).nrows) _Pragma("unroll") for (int m = 0; m < 4; ++m)

struct EpiProj {
    static constexpr bool PERM = true;
    bf16* qkvu; bf16* gates; const float* bgate;
    __device__ __forceinline__ void operator()(const f32x4 (&acc)[2][2][4][2], const Unit& u, int, int wr, int wc, int fr, int fq) const {
        const int row0 = u.row0 + wr * 64 + fr;
        if (u.col0 < QKVU_LD) {
            const int col0 = u.col0 + wc * 32 + 8 * fq;
            EPI_LOOP_AM_H(u) { bf16* rowp = qkvu + (size_t)(row0 + ai * HALF + m * 16) * QKVU_LD + col0;
#pragma unroll
                for (int bj = 0; bj < 2; ++bj) { const f32x4 v0 = acc[ai][bj][m][0], v1 = acc[ai][bj][m][1];
                    u32x4 w; w.x = cvt_pk_bf16(v0[0], v0[1]); w.y = cvt_pk_bf16(v0[2], v0[3]); w.z = cvt_pk_bf16(v1[0], v1[1]); w.w = cvt_pk_bf16(v1[2], v1[3]);
                    *(u32x4*)(rowp + bj * HALF) = w; } }
        } else {
            const int col0 = u.col0 - QKVU_LD + wc * 32 + 8 * fq;
            f32x4 bv[2][2];
#pragma unroll
            for (int bj = 0; bj < 2; ++bj)
#pragma unroll
                for (int n = 0; n < 2; ++n) bv[bj][n] = *(const f32x4*)(bgate + col0 + bj * HALF + 4 * n);
            EPI_LOOP_AM_H(u) { bf16* rowp = gates + (size_t)(row0 + ai * HALF + m * 16) * GATEC + col0;
#pragma unroll
                for (int bj = 0; bj < 2; ++bj) { const f32x4 v0 = acc[ai][bj][m][0] + bv[bj][0], v1 = acc[ai][bj][m][1] + bv[bj][1];
                    u32x4 w; w.x = cvt_pk_bf16(sigm(v0[0]), sigm(v0[1])); w.y = cvt_pk_bf16(sigm(v0[2]), sigm(v0[3])); w.z = cvt_pk_bf16(sigm(v1[0]), sigm(v1[1])); w.w = cvt_pk_bf16(sigm(v1[2]), sigm(v1[3]));
                    *(u32x4*)(rowp + bj * HALF) = w; } }
        }
    }
};
struct EpiGlu {
    static constexpr bool PERM = true;
    const bf16* z; bf16* zg; const float* bglu;
    __device__ __forceinline__ void operator()(const f32x4 (&acc)[2][2][4][2], const Unit& u, int, int wr, int wc, int fr, int fq) const {
        const int row0 = u.row0 + wr * 64 + fr, col0 = u.col0 + wc * 32 + 8 * fq;
        f32x4 bv[2][2];
#pragma unroll
        for (int bj = 0; bj < 2; ++bj)
#pragma unroll
            for (int n = 0; n < 2; ++n) bv[bj][n] = *(const f32x4*)(bglu + col0 + bj * HALF + 4 * n);
        EPI_LOOP_AM_H(u) { const size_t off = (size_t)(row0 + ai * HALF + m * 16) * DSSM + col0;
#pragma unroll
            for (int bj = 0; bj < 2; ++bj) { const u32x4 zz = *(const u32x4*)(z + off + bj * HALF); const f32x4 z0 = bflo4(zz.x, zz.y), z1 = bflo4(zz.z, zz.w);
                const f32x4 v0 = acc[ai][bj][m][0] + bv[bj][0], v1 = acc[ai][bj][m][1] + bv[bj][1];
                u32x4 w; w.x = cvt_pk_bf16(z0[0] * sigm(v0[0]), z0[1] * sigm(v0[1])); w.y = cvt_pk_bf16(z0[2] * sigm(v0[2]), z0[3] * sigm(v0[3]));
                w.z = cvt_pk_bf16(z1[0] * sigm(v1[0]), z1[1] * sigm(v1[1])); w.w = cvt_pk_bf16(z1[2] * sigm(v1[2]), z1[3] * sigm(v1[3]));
                *(u32x4*)(zg + off + bj * HALF) = w; } }
    }
};
template <bool SECOND> struct EpiBranch {
    static constexpr bool PERM = true;
    const bf16* gates; bf16* pa; bf16* merged;
    __device__ __forceinline__ void operator()(const f32x4 (&acc)[2][2][4][2], const Unit& u, int, int wr, int wc, int fr, int fq) const {
        const int row0 = u.row0 + wr * 64 + fr, col0 = u.col0 + wc * 32 + 8 * fq;
        EPI_LOOP_AM { const int row = row0 + ai * HALF + m * 16; const size_t off = (size_t)row * D + col0; const size_t goff = (size_t)row * GATEC + (SECOND ? D : 0) + col0;
#pragma unroll
            for (int bj = 0; bj < 2; ++bj) { const u32x4 gg = *(const u32x4*)(gates + goff + bj * HALF); const f32x4 g0 = bflo4(gg.x, gg.y), g1 = bflo4(gg.z, gg.w);
                f32x4 v0 = acc[ai][bj][m][0] * g0, v1 = acc[ai][bj][m][1] * g1;
                if (SECOND) { const u32x4 pp = *(const u32x4*)(pa + off + bj * HALF); v0 += bflo4(pp.x, pp.y); v1 += bflo4(pp.z, pp.w); }
                u32x4 w; w.x = cvt_pk_bf16(v0[0], v0[1]); w.y = cvt_pk_bf16(v0[2], v0[3]); w.z = cvt_pk_bf16(v1[0], v1[1]); w.w = cvt_pk_bf16(v1[2], v1[3]);
                *(u32x4*)((SECOND ? merged : pa) + off + bj * HALF) = w; } }
    }
};

struct BranchSched {
    StaticOrder so; const char *A1, *B1, *A2, *B2;
    __device__ __forceinline__ bool next(int i, Unit& u) const {
        int pm, pn; if (!so.next(i >> 1, pm, pn)) return false;
        const size_t step = (size_t)256 * 512 * 2; const bool first = (i & 1) == 0;
        u.a = (first ? A1 : A2) + (size_t)pm * step; u.b = (first ? B1 : B2) + (size_t)pn * step; u.aux = first ? 1 : 0;
        u.row0 = pm * BM; u.col0 = pn * BM; u.nrows = BM; u.rt = 0; return true;
    }
};
struct EpiBranch2 {
    static constexpr bool PERM = true;
    const bf16* gates; bf16* merged;
    __device__ __forceinline__ void operator()(f32x4 (&acc)[2][2][4][2], const Unit& u, int, int wr, int wc, int fr, int fq) const {
        const int row0 = u.row0 + wr * 64 + fr, col0 = u.col0 + wc * 32 + 8 * fq;
        if (u.aux == 1) {
            EPI_LOOP_AM { const int row = row0 + ai * HALF + m * 16; const size_t goff = (size_t)row * GATEC + col0;
#pragma unroll
                for (int bj = 0; bj < 2; ++bj) { const u32x4 ga = *(const u32x4*)(gates + goff + bj * HALF), gs = *(const u32x4*)(gates + goff + D + bj * HALF);
                    const f32x4 a0 = bflo4(ga.x, ga.y), a1 = bflo4(ga.z, ga.w), s0 = bflo4(gs.x, gs.y), s1 = bflo4(gs.z, gs.w);
#pragma unroll
                    for (int j = 0; j < 4; ++j) { acc[ai][bj][m][0][j] *= a0[j] * __builtin_amdgcn_rcpf(fmaxf(s0[j], 1e-30f)); acc[ai][bj][m][1][j] *= a1[j] * __builtin_amdgcn_rcpf(fmaxf(s1[j], 1e-30f)); } } }
        } else {
            EPI_LOOP_AM { const int row = row0 + ai * HALF + m * 16; const size_t off = (size_t)row * D + col0; const size_t goff = (size_t)row * GATEC + D + col0;
#pragma unroll
                for (int bj = 0; bj < 2; ++bj) { const u32x4 gg = *(const u32x4*)(gates + goff + bj * HALF); const f32x4 v0 = acc[ai][bj][m][0] * bflo4(gg.x, gg.y), v1 = acc[ai][bj][m][1] * bflo4(gg.z, gg.w);
                    u32x4 w; w.x = cvt_pk_bf16(v0[0], v0[1]); w.y = cvt_pk_bf16(v0[2], v0[3]); w.z = cvt_pk_bf16(v1[0], v1[1]); w.w = cvt_pk_bf16(v1[2], v1[3]);
                    *(u32x4*)(merged + off + bj * HALF) = w; } }
        }
    }
};
struct EpiDelta {
    static constexpr bool PERM = true;
    bf16* delta;
    __device__ __forceinline__ void operator()(const f32x4 (&acc)[2][2][4][2], const Unit& u, int, int wr, int wc, int fr, int fq) const {
        const int row0 = u.row0 + wr * 64 + fr, col0 = u.col0 + wc * 32 + 8 * fq;
        EPI_LOOP_AM { bf16* rowp = delta + (size_t)(row0 + ai * HALF + m * 16) * D + col0;
#pragma unroll
            for (int bj = 0; bj < 2; ++bj) { const f32x4 v0 = acc[ai][bj][m][0], v1 = acc[ai][bj][m][1];
                u32x4 w; w.x = cvt_pk_bf16(v0[0], v0[1]); w.y = cvt_pk_bf16(v0[2], v0[3]); w.z = cvt_pk_bf16(v1[0], v1[1]); w.w = cvt_pk_bf16(v1[2], v1[3]);
                *(u32x4*)(rowp + bj * HALF) = w; } }
    }
};
struct EpiOut {
    static constexpr bool PERM = false;
    const float* x; float* x1;
    __device__ __forceinline__ void operator()(const f32x4 (&acc)[2][2][4][2], const Unit& u, int, int wr, int wc, int fr, int fq) const {
        const int row0 = u.row0 + wr * 64 + fr, col0 = u.col0 + wc * 32 + 4 * fq;
        EPI_LOOP_AM { const size_t off = (size_t)(row0 + ai * HALF + m * 16) * D + col0;
#pragma unroll
            for (int bj = 0; bj < 2; ++bj)
#pragma unroll
                for (int n = 0; n < 2; ++n) { const f32x4 xv = *(const f32x4*)(x + off + bj * HALF + n * 16); *(f32x4*)(x1 + off + bj * HALF + n * 16) = xv + acc[ai][bj][m][n]; } }
    }
};

struct MoeSched {
    const LAS int* tpre; const LAS int* rbase;
    int U, G, c; const char* A; const char* B; size_t bstepE, bstepN, arow; bool gather;
    __device__ __forceinline__ bool next(int i, Unit& u) const {
        int L = i * G + c;
        if (G == 256) { const int xcd = c & 7, slot = c >> 3; L = 4 * (i * 64 + xcd * 8 + (slot >> 2)) + (slot & 3); }
        if (L >= U) return false;
        const int pn = L & 3; const int tile = tpre[L >> 2]; const int e = tile >> 8, rt = tile & 255;
        u.aux = e; u.rt = rt; u.row0 = rbase[e] + rt * BM; const int left = rbase[e + 1] - u.row0; u.nrows = left < BM ? left : BM; u.col0 = pn * BM;
        u.a = gather ? A : A + (size_t)u.row0 * arow; u.b = B + (size_t)e * bstepE + (size_t)pn * bstepN; return true;
    }
};
struct EpiAct {
    static constexpr bool PERM = true;
    bf16* act; const LAS int* rowtab;
    __device__ __forceinline__ void operator()(const f32x4 (&acc)[2][2][4][2], const Unit& u, int ui, int wr, int wc, int fr, int fq) const {
        const int acol = (u.col0 >> 1) + wc * 32 + 8 * fq;
        EPI_LOOP_AM { const int r = ai * HALF + wr * 64 + m * 16 + fr;
            if (r < u.nrows) { const float inv = __int_as_float(rowtab[2 * (ui * 256 + r) + 1]);
                float o[8];
#pragma unroll
                for (int n = 0; n < 2; ++n)
#pragma unroll
                    for (int j = 0; j < 4; ++j) { const float g = acc[ai][0][m][n][j] * inv, uu = acc[ai][1][m][n][j] * inv; o[4 * n + j] = g * sigm(g) * uu; }
                u32x4 w; w.x = cvt_pk_bf16(o[0], o[1]); w.y = cvt_pk_bf16(o[2], o[3]); w.z = cvt_pk_bf16(o[4], o[5]); w.w = cvt_pk_bf16(o[6], o[7]);
                *(u32x4*)(act + (size_t)(u.row0 + r) * DFF + acol) = w; } }
    }
};
struct EpiDown {
    static constexpr bool PERM = true;
    bf16* contrib; const LAS int* rowtab;
    __device__ __forceinline__ void operator()(const f32x4 (&acc)[2][2][4][2], const Unit& u, int ui, int wr, int wc, int fr, int fq) const {
        const int col0 = u.col0 + wc * 32 + 8 * fq;
        EPI_LOOP_AM { const int r = ai * HALF + wr * 64 + m * 16 + fr;
            if (r < u.nrows) { const int ent = rowtab[2 * (ui * 256 + r)]; const float wt = __int_as_float(rowtab[2 * (ui * 256 + r) + 1]);
                bf16* dst = contrib + ((size_t)(ent & 1) * M + (ent >> 1)) * D + col0;
#pragma unroll
                for (int bj = 0; bj < 2; ++bj) { const f32x4 v0 = acc[ai][bj][m][0] * wt, v1 = acc[ai][bj][m][1] * wt;
                    u32x4 w; w.x = cvt_pk_bf16(v0[0], v0[1]); w.y = cvt_pk_bf16(v0[2], v0[3]); w.z = cvt_pk_bf16(v1[0], v1[1]); w.w = cvt_pk_bf16(v1[2], v1[3]);
                    *(u32x4*)(dst + bj * HALF) = w; } } }
    }
};
}


__device__ __forceinline__ float gelu_fast(float x) {
    const float u = 0.7978845608028654f * (x + 0.044715f * x * x * x);
    const float e = __builtin_amdgcn_exp2f(2.885390081777927f * u);
    return 0.5f * x * (2.f - 2.f * __builtin_amdgcn_rcpf(e + 1.f));
}

namespace s5 {
typedef short bf16x8 __attribute__((ext_vector_type(8)));
typedef float f32x16 __attribute__((ext_vector_type(16)));
typedef unsigned u32x2 __attribute__((ext_vector_type(2)));
constexpr int ROWB = 272;
constexpr int WAVE_LDS = 32 * ROWB;
template <bool PHASE_C>
__device__ __forceinline__ void run(int un, const bf16* qkvu, const u32x4* bbt, const u32x4* cmt, const float2* lamb, const float2* lamL, float2* sse, const float* dsk, bf16* zbuf, LAS unsigned char* lds) {
    const int tid = threadIdx.x, lane = tid & 63, w = __builtin_amdgcn_readfirstlane(tid >> 6), j = lane & 31, h = lane >> 5;
    const int b = un >> 7, pair = (un & 127) >> 2, g = (un & 3) * 8 + w;
    const int ksub = 2 * pair + h;
    const float2 lam0 = lamb[g * PS + j], lam1 = lamb[g * PS + 32 + j];
    bf16x8 bfrag[4];
#pragma unroll
    for (int t = 0; t < 4; ++t) bfrag[t] = __builtin_bit_cast(bf16x8, bbt[(g * 4 + t) * 64 + lane]);
    const int r = lane & 31, sA = (r >> 2) & 1, tokA = 4 * (r >> 3) + (r & 3);
    const bf16* up = qkvu + ((size_t)b * SEQ + (size_t)(2 * pair + sA) * LSUB + tokA) * QKVU_LD + UOFF + g * GC + 8 * h;
    u32x4 afr[8];
#pragma unroll
    for (int st = 0; st < 8; ++st) afr[st] = *(const u32x4*)(up + (size_t)st * 16 * QKVU_LD);
    float s0r = 0.f, s0i = 0.f, s1r = 0.f, s1i = 0.f;
    if (PHASE_C) {
        const float2 L0 = lamL[g * PS + j], L1 = lamL[g * PS + 32 + j];
        const float2* e0 = sse + ((size_t)b * NSUB * NG + g) * PS + j;
        const int kmax = 2 * pair + 1;
#pragma unroll 1
        for (int m0 = 0; m0 < kmax; m0 += 16) {
            float2 ea[16], eb[16];
#pragma unroll
            for (int q = 0; q < 16; ++q) { const int m = m0 + q; const int mm = (m < ksub) ? m : 0;
                ea[q] = e0[(size_t)mm * NG * PS]; eb[q] = e0[(size_t)mm * NG * PS + 32]; }
#pragma unroll
            for (int q = 0; q < 16; ++q) { const bool ok = (m0 + q) < ksub;
                const float n0r = opq(opq(L0.x * s0r + ea[q].x) - L0.y * s0i), n0i = opq(opq(L0.x * s0i + ea[q].y) + L0.y * s0r);
                const float n1r = opq(opq(L1.x * s1r + eb[q].x) - L1.y * s1i), n1i = opq(opq(L1.x * s1i + eb[q].y) + L1.y * s1r);
                s0r = ok ? n0r : s0r; s0i = ok ? n0i : s0i; s1r = ok ? n1r : s1r; s1i = ok ? n1i : s1i; }
        }
    }
    bf16x8 cfr[4]; f32x4 dsk4 = {0.f, 0.f, 0.f, 0.f};
    if (PHASE_C) {
#pragma unroll
        for (int ks = 0; ks < 4; ++ks) cfr[ks] = __builtin_bit_cast(bf16x8, cmt[(g * 4 + ks) * 64 + lane]);
        dsk4 = *(const f32x4*)(dsk + g * GC + 4 * (lane >> 4));
    }
    LAS unsigned char* wl = lds + w * WAVE_LDS;
    const f32x16 zero16 = {0.f, 0.f, 0.f, 0.f, 0.f, 0.f, 0.f, 0.f, 0.f, 0.f, 0.f, 0.f, 0.f, 0.f, 0.f, 0.f};
#pragma unroll 1
    for (int st = 0; st < 8; ++st) {
        u32x4 av = afr[0];
#pragma unroll
        for (int q = 1; q < 8; ++q) av = (st == q) ? afr[q] : av;
        const bf16x8 a = __builtin_bit_cast(bf16x8, av);
        f32x16 t0 = __builtin_amdgcn_mfma_f32_32x32x16_bf16(a, bfrag[0], zero16, 0, 0, 0);
        mfma_keep(a, bfrag[0], t0[0]);
        f32x16 t1 = __builtin_amdgcn_mfma_f32_32x32x16_bf16(a, bfrag[1], zero16, 0, 0, 0);
        mfma_keep(a, bfrag[1], t1[0]);
        f32x16 t2 = __builtin_amdgcn_mfma_f32_32x32x16_bf16(a, bfrag[2], zero16, 0, 0, 0);
        mfma_keep(a, bfrag[2], t2[0]);
        f32x16 t3 = __builtin_amdgcn_mfma_f32_32x32x16_bf16(a, bfrag[3], zero16, 0, 0, 0);
        mfma_keep(a, bfrag[3], t3[0]);
#pragma unroll
        for (int i = 0; i < 16; ++i) {
            const float n0r = opq(opq(lam0.x * s0r + t0[i]) - lam0.y * s0i), n0i = opq(opq(lam0.x * s0i + t1[i]) + lam0.y * s0r); s0r = n0r; s0i = n0i;
            const float n1r = opq(opq(lam1.x * s1r + t2[i]) - lam1.y * s1i), n1i = opq(opq(lam1.x * s1i + t3[i]) + lam1.y * s1r); s1r = n1r; s1i = n1i;
            if (PHASE_C) { u32x2 pk; pk.x = pg8::cvt_pk_bf16(s0r, s0i); pk.y = pg8::cvt_pk_bf16(s1r, s1i);
                *(LAS u32x2*)(wl + (h * 16 + i) * ROWB + 8 * j) = pk; }
        }
        if (PHASE_C) {
            asm volatile("" ::: "memory");
#pragma unroll
            for (int nt = 0; nt < 2; ++nt) {
                f32x4 y = {0.f, 0.f, 0.f, 0.f};
#pragma unroll
                for (int ks = 0; ks < 4; ++ks) { const bf16x8 sb = __builtin_bit_cast(bf16x8, *(const LAS u32x4*)(wl + (nt * 16 + (lane & 15)) * ROWB + (ks * 32 + 8 * (lane >> 4)) * 2));
                    y = __builtin_amdgcn_mfma_f32_16x16x32_bf16(cfr[ks], sb, y, 0, 0, 0); mfma_keep(cfr[ks], sb, y[0]); }
                const size_t row = (size_t)b * SEQ + (size_t)(2 * pair + nt) * LSUB + st * 16 + (lane & 15);
                const u32x2 uu = *(const u32x2*)(qkvu + row * QKVU_LD + UOFF + g * GC + 4 * (lane >> 4));
                const f32x4 uf = pg8::bflo4(uu.x, uu.y);
                const f32x4 v = y + dsk4 * uf;
                u32x2 o; o.x = pg8::cvt_pk_bf16(gelu_fast(v[0]), gelu_fast(v[1])); o.y = pg8::cvt_pk_bf16(gelu_fast(v[2]), gelu_fast(v[3]));
                *(u32x2*)(zbuf + row * DSSM + g * GC + 4 * (lane >> 4)) = o;
            }
            asm volatile("" ::: "memory");
        }
    }
    if (!PHASE_C) { float2* e = sse + (((size_t)b * NSUB + ksub) * NG + g) * PS; e[j] = make_float2(s0r, s0i); e[32 + j] = make_float2(s1r, s1i); }
}
}

__device__ __forceinline__ unsigned pk2(float lo, float hi) { return (unsigned)f2bf(lo) | ((unsigned)f2bf(hi) << 16); }
struct CvDesc { const float* W; bf16* dst; const float* ksc; int N, K; };
__device__ __forceinline__ void cv_load(const CvDesc& d, int lane, f32x4 (&tv)[8]) {
    const float* p = d.W + (size_t)(lane >> 3) * d.N + 4 * (lane & 7);
#pragma unroll
    for (int i = 0; i < 8; ++i) tv[i] = __builtin_nontemporal_load((const f32x4*)(p + (size_t)(8 * i) * d.N));
}
__device__ __forceinline__ void cv_finish(const CvDesc& d, int lane, const f32x4 (&tv)[8], LAS float* scr) {
#pragma unroll
    for (int i = 0; i < 8; ++i) { LAS float* w = scr + ((lane >> 3) + 8 * i) * 33 + 4 * (lane & 7); w[0] = tv[i][0]; w[1] = tv[i][1]; w[2] = tv[i][2]; w[3] = tv[i][3]; }
    asm volatile("s_waitcnt lgkmcnt(0)" ::: "memory");
    const int c = lane & 7;
    f32x4 g0 = {1.f, 1.f, 1.f, 1.f}, g1 = g0;
    if (d.ksc) { g0 = *(const f32x4*)(d.ksc + 8 * c); g1 = *(const f32x4*)(d.ksc + 8 * c + 4); }
#pragma unroll
    for (int jj = 0; jj < 4; ++jj) { const int n = (lane >> 3) + 8 * jj; const LAS float* sp = scr + (8 * c) * 33 + n;
        u32x4 o; o.x = pk2(sp[0 * 33] * g0[0], sp[1 * 33] * g0[1]); o.y = pk2(sp[2 * 33] * g0[2], sp[3 * 33] * g0[3]); o.z = pk2(sp[4 * 33] * g1[0], sp[5 * 33] * g1[1]); o.w = pk2(sp[6 * 33] * g1[2], sp[7 * 33] * g1[3]);
        *(u32x4*)(d.dst + (size_t)n * d.K + 8 * c) = o; }
    asm volatile("s_waitcnt lgkmcnt(0)" ::: "memory");
}

namespace att {
typedef short bf16x8 __attribute__((ext_vector_type(8)));
typedef float f32x16 __attribute__((ext_vector_type(16)));
typedef unsigned u32x2 __attribute__((ext_vector_type(2)));
constexpr int KP = 144, VP = 520, V_OFF = 256 * KP;
__device__ __forceinline__ void load_kv(int un, const bf16* qkvu, u32x4 (&kvreg)[8]) {
    const int tid = threadIdx.x, b = un >> 7, nb = (un >> 1) & 63, kvh = un & 1, blk = nb * 128; const size_t rowbase = (size_t)b * SEQ;
#pragma unroll
    for (int cc = 0; cc < 4; ++cc) { const int c = tid + 512 * cc, key = c >> 3, dc = c & 7; int kp = blk - 128 + key; kp = kp < 0 ? 0 : kp;
        const bf16* src = qkvu + (rowbase + kp) * QKVU_LD + kvh * HD + dc * 8;
        kvreg[2 * cc] = *(const u32x4*)(src + KOFF); kvreg[2 * cc + 1] = *(const u32x4*)(src + VOFF); }
}
__device__ __forceinline__ void unit(int un, const bf16* qkvu, const float* sinks, bf16* attn, LAS unsigned char* lds, const u32x4 (&kvreg)[8]) {
    const int tid = threadIdx.x, lane = tid & 63, w = __builtin_amdgcn_readfirstlane(tid >> 6), l31 = lane & 31, h = lane >> 5;
    const int b = un >> 7, nb = (un >> 1) & 63, kvh = un & 1, blk = nb * 128; const size_t rowbase = (size_t)b * SEQ;
    __syncthreads();
#pragma unroll
    for (int cc = 0; cc < 4; ++cc) { const int c = tid + 512 * cc, key = c >> 3, dc = c & 7;
        const u32x4 kv = kvreg[2 * cc], vv = kvreg[2 * cc + 1];
        *(LAS u32x4*)(lds + key * KP + dc * 16) = kv;
#pragma unroll
        for (int i = 0; i < 4; ++i) { *(LAS bf16*)(lds + V_OFF + (dc * 8 + 2 * i) * VP + key * 2) = (bf16)(vv[i] & 0xffffu); *(LAS bf16*)(lds + V_OFF + (dc * 8 + 2 * i + 1) * VP + key * 2) = (bf16)(vv[i] >> 16); } }
    __syncthreads();
    const int hq = kvh * 4 + (w >> 1), qh = w & 1;
    const float sink2 = sinks[hq] * 1.4426950408889634f;
    const float c1 = 0.125f * 1.4426950408889634f;
    const f32x16 zero16 = {0.f, 0.f, 0.f, 0.f, 0.f, 0.f, 0.f, 0.f, 0.f, 0.f, 0.f, 0.f, 0.f, 0.f, 0.f, 0.f};
#pragma unroll 1
    for (int qt = 0; qt < 2; ++qt) {
        const int q0 = qh * 64 + qt * 32, kt0 = q0 >> 5, iq = q0 + l31;
        const size_t qrow = rowbase + blk + iq;
        bf16x8 qf[4];
#pragma unroll
        for (int s = 0; s < 4; ++s) qf[s] = __builtin_bit_cast(bf16x8, *(const u32x4*)(qkvu + qrow * QKVU_LD + QOFF + hq * HD + 16 * s + 8 * h));
        f32x16 sc[5];
#pragma unroll
        for (int t = 0; t < 5; ++t) { f32x16 acc = zero16;
#pragma unroll
            for (int s = 0; s < 4; ++s) { const bf16x8 kf = *(const LAS bf16x8*)(lds + ((kt0 + t) * 32 + l31) * KP + (16 * s + 8 * h) * 2); acc = __builtin_amdgcn_mfma_f32_32x32x16_bf16(kf, qf[s], acc, 0, 0, 0); mfma_keep(kf, qf[s], acc[0]); }
            sc[t] = acc; }
        float mx = sink2;
#pragma unroll
        for (int t = 0; t < 5; ++t)
#pragma unroll
            for (int i = 0; i < 16; ++i) { const int jk = (kt0 + t) * 32 + (i & 3) + 8 * (i >> 2) + 4 * h; const int rel = jk - iq; const bool ok = (rel >= 1) && (rel <= 128) && (blk - 128 + jk >= 0);
                const float v = ok ? sc[t][i] * c1 : -INFINITY; sc[t][i] = v; mx = fmaxf(mx, v); }
        mx = fmaxf(mx, __shfl_xor(mx, 32));
        float sum = 0.f;
#pragma unroll
        for (int t = 0; t < 5; ++t)
#pragma unroll
            for (int i = 0; i < 16; ++i) { const float p = __builtin_amdgcn_exp2f(sc[t][i] - mx); sc[t][i] = p; sum += p; }
        sum += __shfl_xor(sum, 32);
        const float rinv = 1.f / (sum + __builtin_amdgcn_exp2f(sink2 - mx));
        f32x16 o0 = zero16, o1 = zero16;
#pragma unroll
        for (int t = 0; t < 5; ++t)
#pragma unroll
            for (int s = 0; s < 2; ++s) {
                u32x4 pw; pw.x = pg8::cvt_pk_bf16(sc[t][8 * s + 0], sc[t][8 * s + 1]); pw.y = pg8::cvt_pk_bf16(sc[t][8 * s + 2], sc[t][8 * s + 3]); pw.z = pg8::cvt_pk_bf16(sc[t][8 * s + 4], sc[t][8 * s + 5]); pw.w = pg8::cvt_pk_bf16(sc[t][8 * s + 6], sc[t][8 * s + 7]);
                const bf16x8 pb = __builtin_bit_cast(bf16x8, pw);
                const int kofs = ((kt0 + t) * 32 + 16 * s + 4 * h) * 2;
                { const u32x2 a = *(const LAS u32x2*)(lds + V_OFF + l31 * VP + kofs), c = *(const LAS u32x2*)(lds + V_OFF + l31 * VP + kofs + 16); u32x4 vw; vw.x = a.x; vw.y = a.y; vw.z = c.x; vw.w = c.y;
                  const bf16x8 va = __builtin_bit_cast(bf16x8, vw); o0 = __builtin_amdgcn_mfma_f32_32x32x16_bf16(va, pb, o0, 0, 0, 0); mfma_keep(va, pb, o0[0]); }
                { const u32x2 a = *(const LAS u32x2*)(lds + V_OFF + (32 + l31) * VP + kofs), c = *(const LAS u32x2*)(lds + V_OFF + (32 + l31) * VP + kofs + 16); u32x4 vw; vw.x = a.x; vw.y = a.y; vw.z = c.x; vw.w = c.y;
                  const bf16x8 va = __builtin_bit_cast(bf16x8, vw); o1 = __builtin_amdgcn_mfma_f32_32x32x16_bf16(va, pb, o1, 0, 0, 0); mfma_keep(va, pb, o1[0]); }
            }
        bf16* orow = attn + qrow * DATT + hq * HD + 4 * h;
#pragma unroll
        for (int a = 0; a < 4; ++a) { u32x2 w0, w1; w0.x = pg8::cvt_pk_bf16(o0[4 * a] * rinv, o0[4 * a + 1] * rinv); w0.y = pg8::cvt_pk_bf16(o0[4 * a + 2] * rinv, o0[4 * a + 3] * rinv);
            w1.x = pg8::cvt_pk_bf16(o1[4 * a] * rinv, o1[4 * a + 1] * rinv); w1.y = pg8::cvt_pk_bf16(o1[4 * a + 2] * rinv, o1[4 * a + 3] * rinv);
            *(u32x2*)(orow + 8 * a) = w0; *(u32x2*)(orow + 32 + 8 * a) = w1; }
    }
}
}

#define XB_TMO      128
#define XB_XCNT(j)  (256  + 64 * (j))
#define XB_XSUB(j)  (1280 + 64 * (j))
#define XB_XGEN(j)  (2304 + 64 * (j))
#define XB_TOP      3328
#define XB_TOPGEN   3392
#define XCD_BAR_WORDS 3456
#ifndef XB_SPIN_CAP
#define XB_SPIN_CAP (1u << 24)
#endif
__device__ __forceinline__ unsigned xb_ld(unsigned* p)              { return __hip_atomic_load(p, __ATOMIC_RELAXED, __HIP_MEMORY_SCOPE_AGENT); }
__device__ __forceinline__ unsigned xb_add(unsigned* p, unsigned v) { return __hip_atomic_fetch_add(p, v, __ATOMIC_RELAXED, __HIP_MEMORY_SCOPE_AGENT); }
__device__ __forceinline__ unsigned xb_xcc_id() { return (unsigned)__builtin_amdgcn_s_getreg((3 << 11) | 20) & 0xFu; }
#define XB_SPIN(cond, bar) do { unsigned _sp = 0; while (cond) { __builtin_amdgcn_s_sleep(1); \
    if ((++_sp & 255u) == 0u) { if (xb_ld(&(bar)[XB_TMO])) break; if (_sp > XB_SPIN_CAP) { atomicAdd(&(bar)[XB_TMO], 1u); break; } } } } while (0)
struct XcdBarrier { unsigned* bar; unsigned x; volatile LAS unsigned* st; };
__device__ __forceinline__ XcdBarrier xcd_barrier_post(unsigned* bar, volatile LAS unsigned* st) {
    XcdBarrier b; b.bar = bar; b.x = xb_xcc_id(); b.st = st;
    if (threadIdx.x == 0) (void)xb_add(&bar[XB_XCNT(b.x)], 1u);
    return b;
}
__device__ __forceinline__ void xcd_barrier_complete(unsigned* bar, unsigned x, unsigned& nloc, unsigned& nx) {
    const unsigned G = gridDim.x * gridDim.y * gridDim.z;
    unsigned sum, cnt, mine, sp = 0u;
    for (;;) {
        sum = 0u; cnt = 0u; mine = 0u;
#pragma unroll
        for (unsigned j = 0; j < 16; ++j) { const unsigned c = xb_ld(&bar[XB_XCNT(j)]); sum += c; cnt += (c > 0u) ? 1u : 0u; mine = (j == x) ? c : mine; }
        if (sum == G) break;
        __builtin_amdgcn_s_sleep(1);
        if ((++sp & 255u) == 0u) { if (xb_ld(&bar[XB_TMO])) break; if (sp > XB_SPIN_CAP) { atomicAdd(&bar[XB_TMO], 1u); break; } }
    }
    nloc = mine > 0u ? mine : 1u; nx = cnt > 0u ? cnt : 1u;
}
__device__ __forceinline__ void xcd_barrier(const XcdBarrier& b) {
    asm volatile("s_waitcnt vmcnt(0)" ::: "memory");
    __syncthreads();
    if (threadIdx.x == 0) {
        unsigned* bar = b.bar;
        __builtin_amdgcn_s_waitcnt(0);
        unsigned nloc = b.st[0], nx = b.st[1];
        if (nloc == 0u) { xcd_barrier_complete(bar, b.x, nloc, nx); b.st[0] = nloc; b.st[1] = nx; }
        const unsigned old = xb_add(&bar[XB_XSUB(b.x)], 1u);
        const unsigned gen = old / nloc;
        if (old + 1u == (gen + 1u) * nloc) {
            __builtin_amdgcn_fence(__ATOMIC_RELEASE, "agent");
            asm volatile("s_waitcnt vmcnt(0)" ::: "memory");
            const unsigned og = xb_add(&bar[XB_TOP], 1u);
            const unsigned tg = og / nx;
            if (og + 1u == (tg + 1u) * nx) xb_add(&bar[XB_TOPGEN], 1u);
            else XB_SPIN(xb_ld(&bar[XB_TOPGEN]) == tg, bar);
            __builtin_amdgcn_fence(__ATOMIC_ACQUIRE, "agent");
            xb_add(&bar[XB_XGEN(b.x)], 1u);
            asm volatile("s_waitcnt vmcnt(0)" ::: "memory");
        } else {
            XB_SPIN(xb_ld(&bar[XB_XGEN(b.x)]) == gen, bar);
            __builtin_amdgcn_fence(__ATOMIC_ACQUIRE, "agent");
            asm volatile("s_waitcnt vmcnt(0)" ::: "memory");
        }
    }
    __syncthreads();
}

struct XbTicket { unsigned mode, val; };
__device__ __forceinline__ XbTicket xcd_barrier_arrive(const XcdBarrier& b) {
    XbTicket t; t.mode = 0u; t.val = 0u;
    asm volatile("s_waitcnt vmcnt(0)" ::: "memory");
    __syncthreads();
    if (threadIdx.x == 0) {
        unsigned* bar = b.bar;
        __builtin_amdgcn_s_waitcnt(0);
        unsigned nloc = b.st[0], nx = b.st[1];
        if (nloc == 0u) { xcd_barrier_complete(bar, b.x, nloc, nx); b.st[0] = nloc; b.st[1] = nx; }
        const unsigned old = xb_add(&bar[XB_XSUB(b.x)], 1u);
        const unsigned gen = old / nloc;
        if (old + 1u == (gen + 1u) * nloc) {
            __builtin_amdgcn_fence(__ATOMIC_RELEASE, "agent");
            asm volatile("s_waitcnt vmcnt(0)" ::: "memory");
            const unsigned og = xb_add(&bar[XB_TOP], 1u);
            const unsigned tg = og / nx;
            if (og + 1u == (tg + 1u) * nx) { xb_add(&bar[XB_TOPGEN], 1u); t.mode = 0u; }
            else { t.mode = 1u; t.val = tg; }
        } else { t.mode = 2u; t.val = gen; }
    }
    return t;
}
__device__ __forceinline__ void xcd_barrier_wait(const XcdBarrier& b, const XbTicket& t) {
    asm volatile("s_waitcnt vmcnt(0)" ::: "memory");
    __syncthreads();
    if (threadIdx.x == 0) {
        unsigned* bar = b.bar;
        if (t.mode <= 1u) {
            if (t.mode == 1u) XB_SPIN(xb_ld(&bar[XB_TOPGEN]) == t.val, bar);
            __builtin_amdgcn_fence(__ATOMIC_ACQUIRE, "agent");
            xb_add(&bar[XB_XGEN(b.x)], 1u);
            asm volatile("s_waitcnt vmcnt(0)" ::: "memory");
        } else {
            XB_SPIN(xb_ld(&bar[XB_XGEN(b.x)]) == t.val, bar);
            __builtin_amdgcn_fence(__ATOMIC_ACQUIRE, "agent");
            asm volatile("s_waitcnt vmcnt(0)" ::: "memory");
        }
    }
    __syncthreads();
}

struct Args { const float* in[27]; float* out; unsigned char* ws; int ph_lo, ph_hi; };

template <class F>
__device__ __forceinline__ void naive_gemm(const bf16* A, int lda, const bf16* Bt, int ldb, int Mr, int N, int K, F epi, long gt, long NT) {
    for (long idx = gt; idx < (long)Mr * N; idx += NT) {
        const int m = (int)(idx / N), n = (int)(idx % N);
        const u32x4* a = (const u32x4*)(A + (size_t)m * lda); const u32x4* b = (const u32x4*)(Bt + (size_t)n * ldb);
        float acc = 0.f;
#pragma unroll 4
        for (int k8 = 0; k8 < K / 8; ++k8) acc += dot8(a[k8], b[k8]);
        epi(m, n, acc);
    }
}

__global__ void __launch_bounds__(NTHREADS, 2) fwd(Args args) {
    extern __shared__ __attribute__((aligned(16))) unsigned char lds[];
#define PH_IDX const int tid = threadIdx.x, lane = tid & 63, wave = tid >> 6; const long gt = (long)blockIdx.x * NTHREADS + tid, NT = (long)gridDim.x * NTHREADS; \
    const int gw = blockIdx.x * NWAVES + wave, NW = gridDim.x * NWAVES; (void)lane; (void)gt; (void)NT; (void)gw; (void)NW;
    unsigned char* ws = args.ws;
    unsigned* ctl = (unsigned*)(ws + WS_CTL);
    const float* x = args.in[0];
    float* out = args.out;
    unsigned char* dout_b = (unsigned char*)args.out;
    bf16* WinT = (bf16*)(ws + WS_WIN); bf16* WgluT = (bf16*)(ws + WS_WGLU); bf16* WaT = (bf16*)(ws + WS_WA); bf16* WsT = (bf16*)(ws + WS_WS); bf16* WoutT = (bf16*)(ws + WS_WOUT);
    bf16* WguT = (bf16*)(ws + WS_WGU); bf16* WdT = (bf16*)(ws + WS_WD);
    bf16* hbuf = (bf16*)(ws + WS_R1); bf16* act = (bf16*)(ws + WS_R1); bf16* pabuf = (bf16*)(ws + WS_R1);
    LAS unsigned char* ldsp = (LAS unsigned char*)lds;
    bf16* gates = (bf16*)(ws + WS_GATES); bf16* delta = (bf16*)(ws + WS_GATES);
    bf16* contrib = (bf16*)(ws + WS_WGU);
    bf16* qkvu = (bf16*)(ws + WS_QKVU); bf16* merged = (bf16*)(ws + WS_QKVU); bf16* h2u = (bf16*)(ws + WS_QKVU);
    bf16* attn = (bf16*)(dout_b + DO_ATTN); bf16* zbuf = (bf16*)(dout_b + DO_Z); bf16* zg = (bf16*)(dout_b + DO_ZG);
    float2* lamb = (float2*)(ws + WS_PAR + PAR_LAMB); float2* lamL = (float2*)(ws + WS_PAR + PAR_LAML); float2* bbar = (float2*)(ws + WS_PAR + PAR_BBAR);
    u32x4* bbt = (u32x4*)(ws + WS_PAR + PAR_BBT); u32x4* cmt = (u32x4*)(ws + WS_PAR + PAR_CMT); float2* sse = (float2*)(ws + WS_SSE);
    bf16* rwh = (bf16*)(ws + WS_PAR + PAR_RWH); bf16* rwl = (bf16*)(ws + WS_PAR + PAR_RWL);
    int2* lists = (int2*)(ws + WS_LIST);
    int* tok_e = (int*)(ws + WS_TOK + TOK_E); int* tok_slot = (int*)(ws + WS_TOK + TOK_SLOT); float* tok_w = (float*)(ws + WS_TOK + TOK_W); float* tok_inv = (float*)(ws + WS_TOK + TOK_INV);
    unsigned* ecnt = ctl + CW_CNT;
    const int lo = args.ph_lo, hi = args.ph_hi;
#define IN(k) (lo <= (k) && (k) < hi)
#define BOTH(k, k2) (IN(k) && IN(k2))
    if (threadIdx.x < 4) ((LAS unsigned*)(ldsp + LDS_BARW))[threadIdx.x] = 0u;
    __syncthreads();
    XcdBarrier gbar; gbar.bar = ctl + CW_BAR; gbar.x = 0; gbar.st = nullptr;
    if (hi - lo > 1) gbar = xcd_barrier_post(ctl + CW_BAR, (volatile LAS unsigned*)(ldsp + LDS_BARW));
#define GRID_BAR(k, k2) do { if (BOTH(k, k2)) xcd_barrier(gbar); } while (0)

    constexpr int CV_IN = (D / 64) * (INC / 32), CV_GLU = (DSSM / 64) * (DSSM / 32), CV_A = (DATT / 64) * (D / 32), CV_S = (DSSM / 64) * (D / 32), CV_O = (D / 64) * (D / 32);
    constexpr int CV_EG = (D / 64) * (DFF / 32), CV_ED = (DFF / 64) * (D / 32);
    constexpr int CV_ALL = CV_IN + CV_GLU + CV_A + CV_S + CV_O + NE * (2 * CV_EG + CV_ED);
    auto cv_decode = [&](int r) __attribute__((always_inline)) -> CvDesc {
        CvDesc d; d.ksc = nullptr;
        if (r < CV_IN) { const int nb = INC / 32, k0 = 64 * (r / nb), n0 = 32 * (r % nb); d.W = args.in[2] + (size_t)k0 * INC + n0; d.N = INC; d.K = D; d.dst = WinT + (size_t)n0 * D + k0; return d; } r -= CV_IN;
        if (r < CV_GLU) { const int nb = DSSM / 32, k0 = 64 * (r / nb), n0 = 32 * (r % nb); d.W = args.in[13] + (size_t)k0 * DSSM + n0; d.N = DSSM; d.K = DSSM; d.dst = WgluT + (size_t)n0 * DSSM + k0; return d; } r -= CV_GLU;
        if (r < CV_A) { const int nb = D / 32, k0 = 64 * (r / nb), n0 = 32 * (r % nb); d.W = args.in[15] + (size_t)k0 * D + n0; d.N = D; d.K = DATT; d.dst = WaT + (size_t)n0 * DATT + k0; return d; } r -= CV_A;
        if (r < CV_S) { const int nb = D / 32, k0 = 64 * (r / nb), n0 = 32 * (r % nb); d.W = args.in[16] + (size_t)k0 * D + n0; d.N = D; d.K = DSSM; d.dst = WsT + (size_t)n0 * DSSM + k0; return d; } r -= CV_S;
        if (r < CV_O) { const int nb = D / 32, k0 = 64 * (r / nb), n0 = 32 * (r % nb); d.W = args.in[17] + (size_t)k0 * D + n0; d.N = D; d.K = D; d.dst = WoutT + (size_t)n0 * D + k0; return d; } r -= CV_O;
        if (r < NE * 2 * CV_EG) { const int e = r / (2 * CV_EG); r -= e * (2 * CV_EG); const int up = r >= CV_EG; if (up) r -= CV_EG; const int nb = DFF / 32, k0 = 64 * (r / nb), n0 = 32 * (r % nb);
            const int np0 = 256 * (n0 >> 7) + (n0 & 127) + (up ? 128 : 0);
            d.W = (up ? args.in[24] : args.in[23]) + ((size_t)e * D + k0) * DFF + n0; d.N = DFF; d.K = D; d.dst = WguT + ((size_t)e * 1024 + np0) * D + k0; d.ksc = args.in[18] + k0; return d; }
        r -= NE * 2 * CV_EG;
        { const int e = r / CV_ED; r -= e * CV_ED; const int nb = D / 32, k0 = 64 * (r / nb), n0 = 32 * (r % nb); d.W = args.in[25] + ((size_t)e * DFF + k0) * D + n0; d.N = D; d.K = DFF; d.dst = WdT + ((size_t)e * D + n0) * DFF + k0; }
        return d;
    };
    auto cv_run = [&](int first, int stride, int count, LAS float* scr, int lane) __attribute__((always_inline)) {
        if (count <= 0) return;
        f32x4 t0[8], t1[8], t2[8], t3[8];
        CvDesc d0 = cv_decode(first), d1 = d0, d2 = d0, d3 = d0;
        cv_load(d0, lane, t0);
        if (count > 1) { d1 = cv_decode(first + stride); cv_load(d1, lane, t1); }
        if (count > 2) { d2 = cv_decode(first + 2 * stride); cv_load(d2, lane, t2); }
#pragma unroll 1
        for (int j = 0; j < count; j += 4) {
            if (j + 3 < count) { d3 = cv_decode(first + (j + 3) * stride); cv_load(d3, lane, t3); }
            cv_finish(d0, lane, t0, scr);
            if (j + 4 < count) { d0 = cv_decode(first + (j + 4) * stride); cv_load(d0, lane, t0); }
            if (j + 1 < count) cv_finish(d1, lane, t1, scr);
            if (j + 5 < count) { d1 = cv_decode(first + (j + 5) * stride); cv_load(d1, lane, t1); }
            if (j + 2 < count) cv_finish(d2, lane, t2, scr);
            if (j + 6 < count) { d2 = cv_decode(first + (j + 6) * stride); cv_load(d2, lane, t2); }
            if (j + 3 < count) cv_finish(d3, lane, t3, scr);
        }
    };

    if (IN(0)) {
        PH_IDX
#if FAST_P0
        {
            LAS float* scr = (LAS float*)(ldsp + wave * 8448);
            cv_run(gw, NW, (CV_IN + CV_P0X - gw + NW - 1) / NW, scr, lane);
        }
        { const float* g = args.in[1]; f32x4 gv[4];
#pragma unroll
          for (int j = 0; j < 4; ++j) gv[j] = *(const f32x4*)(g + 256 * j + 4 * lane);
          f32x4 vn[4];
          if (gw < M) {
#pragma unroll
              for (int j = 0; j < 4; ++j) vn[j] = *(const f32x4*)(x + (size_t)gw * D + 256 * j + 4 * lane); }
#pragma unroll 1
          for (int m = gw; m < M; m += NW) { f32x4 v[4]; float ss = 0.f;
#pragma unroll
              for (int j = 0; j < 4; ++j) v[j] = vn[j];
              if (m + NW < M) {
#pragma unroll
                  for (int j = 0; j < 4; ++j) vn[j] = *(const f32x4*)(x + (size_t)(m + NW) * D + 256 * j + 4 * lane); }
#pragma unroll
              for (int j = 0; j < 4; ++j) ss += v[j][0] * v[j][0] + v[j][1] * v[j][1] + v[j][2] * v[j][2] + v[j][3] * v[j][3];
              const float inv = 1.f / sqrtf(wave_sum(ss) * (1.f / D) + EPS);
#pragma unroll
              for (int j = 0; j < 4; ++j) { const f32x4 t = v[j] * inv * gv[j]; unsigned long long o = (unsigned long long)pk2(t[0], t[1]) | ((unsigned long long)pk2(t[2], t[3]) << 32);
                  *(unsigned long long*)(hbuf + (size_t)m * D + 256 * j + 4 * lane) = o; } } }
#else
        { const float* W = args.in[2]; for (long i = gt; i < (long)INC * D; i += NT) { const int n = (int)(i / D), k = (int)(i % D); WinT[i] = f2bf(W[(size_t)k * INC + n]); } }
        { const float* W = args.in[13]; for (long i = gt; i < (long)DSSM * DSSM; i += NT) { const int n = (int)(i / DSSM), k = (int)(i % DSSM); WgluT[i] = f2bf(W[(size_t)k * DSSM + n]); } }
        { const float* W = args.in[15]; for (long i = gt; i < (long)D * DATT; i += NT) { const int n = (int)(i / DATT), k = (int)(i % DATT); WaT[i] = f2bf(W[(size_t)k * D + n]); } }
        { const float* W = args.in[16]; for (long i = gt; i < (long)D * DSSM; i += NT) { const int n = (int)(i / DSSM), k = (int)(i % DSSM); WsT[i] = f2bf(W[(size_t)k * D + n]); } }
        { const float* W = args.in[17]; for (long i = gt; i < (long)D * D; i += NT) { const int n = (int)(i / D), k = (int)(i % D); WoutT[i] = f2bf(W[(size_t)k * D + n]); } }
        { const float* Wg = args.in[23]; const float* Wu = args.in[24];
          for (long i = gt; i < (long)NE * 1024 * D; i += NT) { const int k = (int)(i % D); const int np = (int)((i / D) % 1024); const int e = (int)(i / ((long)D * 1024));
              const int pn = np >> 8, bj = (np >> 7) & 1, jj = np & 127; const float* W = bj ? Wu : Wg;
              WguT[i] = f2bf(W[((size_t)e * D + k) * DFF + 128 * pn + jj]); } }
        { const float* W = args.in[25];
          for (long i = gt; i < (long)NE * D * DFF; i += NT) { const int k = (int)(i % DFF); const int n = (int)((i / DFF) % D); const int e = (int)(i / ((long)DFF * D));
              WdT[i] = f2bf(W[((size_t)e * DFF + k) * D + n]); } }
        { const float* g = args.in[1];
          for (int m = gw; m < M; m += NW) { const float* xr = x + (size_t)m * D; float v[16]; float ss = 0.f;
#pragma unroll
              for (int j = 0; j < 4; ++j) { const f32x4 t = *(const f32x4*)(xr + 256 * j + 4 * lane); v[4 * j] = t[0]; v[4 * j + 1] = t[1]; v[4 * j + 2] = t[2]; v[4 * j + 3] = t[3]; ss += t[0] * t[0] + t[1] * t[1] + t[2] * t[2] + t[3] * t[3]; }
              const float inv = 1.f / sqrtf(wave_sum(ss) * (1.f / D) + EPS);
#pragma unroll
              for (int j = 0; j < 4; ++j)
#pragma unroll
                  for (int i = 0; i < 4; ++i) { const int k = 256 * j + 4 * lane + i; hbuf[(size_t)m * D + k] = f2bf(v[4 * j + i] * inv * g[k]); } } }
#endif
        for (long i = gt; i < 48 * D; i += NT) { const int n = (int)(i / D), k = (int)(i % D);
            const float wv = (n < NEG) ? args.in[19][(size_t)k * NEG + n] : (n < NEG + NE) ? args.in[21][(size_t)k * NE + (n - NEG)] : 0.f;
            const bf16 hb = f2bf(wv); rwh[i] = hb; rwl[i] = f2bf(wv - bf2f(hb)); }
        const int tb0 = ((int)gridDim.x == 256) ? 64 : 0, tbn = (int)gridDim.x - tb0, tbi = (int)blockIdx.x - tb0;
        const long tfirst = tbi >= 0 ? (long)tid * tbn + tbi : (long)(1 << 30), tstep = (long)tbn * NTHREADS;
        for (long i = tfirst; i < NG * 4 * 64; i += tstep) { const int l = (int)(i & 63), t = (int)((i >> 6) & 3), g = (int)(i >> 8);
            { const int p = (t >> 1) * 32 + (l & 31), part = t & 1; const int gp = g * PS + p;
              const double are = (double)args.in[5][gp], aim = (double)args.in[6][gp], dt = dexp_((double)args.in[12][g]);
              double s, c; dsincos_(aim * dt, s, c); const double er = dexp_(are * dt); const double lr = er * c, li = er * s;
              const double nx = lr - 1.0, ny = li, den = are * are + aim * aim; const double cr = (nx * are + ny * aim) / den, ci = (ny * are - nx * aim) / den;
              unsigned wv[4];
#pragma unroll
              for (int i2 = 0; i2 < 4; ++i2) { float v2[2];
#pragma unroll
                  for (int q = 0; q < 2; ++q) { const int cc = 8 * (l >> 5) + 2 * i2 + q; const double br = (double)args.in[7][gp * GC + cc], bi = (double)args.in[8][gp * GC + cc];
                      v2[q] = part ? (float)(cr * bi + ci * br) : (float)(cr * br - ci * bi); }
                  wv[i2] = (unsigned)f2bf(v2[0]) | ((unsigned)f2bf(v2[1]) << 16); }
              u32x4 o; o.x = wv[0]; o.y = wv[1]; o.z = wv[2]; o.w = wv[3]; bbt[i] = o; }
            { const int ks = t, c = l & 15; unsigned wv[4];
#pragma unroll
              for (int i2 = 0; i2 < 4; ++i2) { float v2[2];
#pragma unroll
                  for (int q = 0; q < 2; ++q) { const int kk = ks * 32 + 8 * (l >> 4) + 2 * i2 + q; const int jj = kk >> 2, qq = kk & 3; const int p = jj + 32 * (qq >> 1);
                      v2[q] = (qq & 1) ? -args.in[10][(g * GC + c) * PS + p] : args.in[9][(g * GC + c) * PS + p]; }
                  wv[i2] = (unsigned)f2bf(v2[0]) | ((unsigned)f2bf(v2[1]) << 16); }
              u32x4 o; o.x = wv[0]; o.y = wv[1]; o.z = wv[2]; o.w = wv[3]; cmt[i] = o; } }
        for (long i = tfirst; i < NG * PS; i += tstep) { const int g = (int)(i / PS);
            const double are = (double)args.in[5][i], aim = (double)args.in[6][i], dt = dexp_((double)args.in[12][g]);
            double s, c; dsincos_(aim * dt, s, c); const double er = dexp_(are * dt); const double lr = er * c, li = er * s;
            lamb[i] = make_float2((float)lr, (float)li);
            double sL, cL; dsincos_(aim * dt * LSUB, sL, cL); const double eL = dexp_(are * dt * LSUB); lamL[i] = make_float2((float)(eL * cL), (float)(eL * sL));
            const double nx = lr - 1.0, ny = li, den = are * are + aim * aim; const double cr = (nx * are + ny * aim) / den, ci = (ny * are - nx * aim) / den;
#pragma unroll
            for (int cc = 0; cc < GC; ++cc) { const double br = (double)args.in[7][i * GC + cc], bi = (double)args.in[8][i * GC + cc];
                bbar[i * GC + cc] = make_float2((float)(cr * br - ci * bi), (float)(cr * bi + ci * br)); } }
    }

    GRID_BAR(0, 1);
#if FAST_P1
    if (IN(1)) {
        const bool split = (int)gridDim.x == 256;
        const int NGW = split ? CV_NGW : (int)gridDim.x;
        if ((int)blockIdx.x < NGW) {
            pg8::DenseSched S; S.so.init(M, INC, NGW, (int)blockIdx.x); S.A = (const char*)hbuf; S.B = (const char*)WinT; S.astep = (size_t)256 * D * 2; S.bstep = (size_t)256 * D * 2;
            S.nfull = (S.so.nwg / S.so.G) * S.so.G;
            pg8::EpiProj E{qkvu, gates, args.in[3]};
            pg8::gemm_phase<pg8::EpiProj, pg8::DenseSched, false, true>(ldsp, D, D, D, S, E, nullptr);
        }
        {   int tq = (int)threadIdx.x; asm volatile("" : "+v"(tq));
            const int lane = tq & 63, wave = __builtin_amdgcn_readfirstlane(tq >> 6), gw = (int)blockIdx.x * NWAVES + wave, NW = (int)gridDim.x * NWAVES;
            LAS float* scr = (LAS float*)(ldsp + wave * 8448);
            const int nsw = ((int)gridDim.x - NGW) * NWAVES;
            int done = CV_IN + CV_P0X;
            if (split) {
                if ((int)blockIdx.x >= NGW) { const int sw = ((int)blockIdx.x - NGW) * NWAVES + wave; cv_run(done + sw, nsw, CV_STREAM_J, scr, lane); }
                done += CV_STREAM_J * nsw;
            }
            if (split && CV_TAIL_J > 0) {
                const int nhalfw = 2 * (13 * 64 - (13 * 64 / NGW) * NGW), ntw = NGW - nhalfw;
                if ((int)blockIdx.x >= nhalfw && (int)blockIdx.x < NGW) cv_run(done + ((int)blockIdx.x - nhalfw) * NWAVES + wave, ntw * NWAVES, CV_TAIL_J, scr, lane);
                done += CV_TAIL_J * ntw * NWAVES;
            }
            cv_run(done + gw, NW, (CV_ALL - CV_P8X - done - gw + NW - 1) / NW, scr, lane);
        }
    }

#else
    if (IN(1)) {
        PH_IDX
        const float* bg = args.in[3];
        naive_gemm(hbuf, D, WinT, D, M, INC, D, [&](int m, int n, float acc) {
            if (n < QKVU_LD) qkvu[(size_t)m * QKVU_LD + n] = f2bf(acc);
            else gates[(size_t)m * GATEC + (n - QKVU_LD)] = f2bf(sigmoidf_(acc + bg[n - QKVU_LD])); }, gt, NT);
    }

#endif
    GRID_BAR(1, 2);
    if (IN(2)) {
        PH_IDX
#if FAST_ATT
#else
        const float* sinks = args.in[4];
        for (int task = gw; task < M * NH; task += NW) {
            const int h = task % NH, row = task / NH, t = row % SEQ, kvh = h / 4;
            const bf16* q = qkvu + (size_t)row * QKVU_LD + QOFF + h * HD;
            const float sink = sinks[h];
            const int t0 = t - lane, t1 = t - 64 - lane;
            float s0 = -3.0e38f, s1 = -3.0e38f;
            if (t0 >= 0) { const bf16* k = qkvu + (size_t)(row - lane) * QKVU_LD + KOFF + kvh * HD; float a = 0.f;
#pragma unroll
                for (int d8 = 0; d8 < 8; ++d8) a += dot8(*(const u32x4*)(q + 8 * d8), *(const u32x4*)(k + 8 * d8));
                s0 = a * 0.125f; }
            if (t1 >= 0) { const bf16* k = qkvu + (size_t)(row - 64 - lane) * QKVU_LD + KOFF + kvh * HD; float a = 0.f;
#pragma unroll
                for (int d8 = 0; d8 < 8; ++d8) a += dot8(*(const u32x4*)(q + 8 * d8), *(const u32x4*)(k + 8 * d8));
                s1 = a * 0.125f; }
            const float mx = fmaxf(wave_max(fmaxf(s0, s1)), sink);
            const float p0 = (t0 >= 0) ? __expf(s0 - mx) : 0.f, p1 = (t1 >= 0) ? __expf(s1 - mx) : 0.f;
            const float denom = wave_sum(p0 + p1) + __expf(sink - mx);
            float o = 0.f;
            for (int j = 0; j < 64; ++j) { const float pj = __shfl(p0, j); if (t - j >= 0) o += pj * bf2f(qkvu[(size_t)(row - j) * QKVU_LD + VOFF + kvh * HD + lane]); }
            for (int j = 0; j < 64; ++j) { const float pj = __shfl(p1, j); if (t - 64 - j >= 0) o += pj * bf2f(qkvu[(size_t)(row - 64 - j) * QKVU_LD + VOFF + kvh * HD + lane]); }
            attn[(size_t)row * DATT + h * HD + lane] = f2bf(o / denom);
        }
#endif
#if FAST_S5
        for (int un = (int)blockIdx.x; un < 256; un += (int)gridDim.x) {
            u32x4 kvreg[8]; att::load_kv(un, qkvu, kvreg);
            s5::run<false>(un, qkvu, bbt, cmt, lamb, lamL, sse, args.in[11], zbuf, ldsp);
            att::unit(un, qkvu, args.in[4], attn, ldsp, kvreg);
        }
#else
        const float* cre = args.in[9]; const float* cim = args.in[10]; const float* dsk = args.in[11];
        for (int bgi = gw; bgi < BATCH * NG; bgi += NW) {
            const int b = bgi / NG, g = bgi % NG;
            const float2 lam = lamb[g * PS + lane];
            float br[GC], bi[GC], cr[GC], ci[GC];
#pragma unroll
            for (int c = 0; c < GC; ++c) { const float2 bb = bbar[(g * PS + lane) * GC + c]; br[c] = bb.x; bi[c] = bb.y; cr[c] = cre[(g * GC + c) * PS + lane]; ci[c] = cim[(g * GC + c) * PS + lane]; }
            const float dmine = dsk[g * GC + (lane & 15)];
            float sr = 0.f, si = 0.f;
            for (int t = 0; t < SEQ; ++t) {
                const size_t row = (size_t)b * SEQ + t;
                const bf16* up = qkvu + row * QKVU_LD + UOFF + g * GC;
                const u32x4 ua = *(const u32x4*)up, ub = *(const u32x4*)(up + 8);
                float u[GC];
#pragma unroll
                for (int j = 0; j < 4; ++j) { u[2 * j] = __uint_as_float(ua[j] << 16); u[2 * j + 1] = __uint_as_float(ua[j] & 0xffff0000u); u[8 + 2 * j] = __uint_as_float(ub[j] << 16); u[8 + 2 * j + 1] = __uint_as_float(ub[j] & 0xffff0000u); }
                float bur = 0.f, bui = 0.f;
#pragma unroll
                for (int c = 0; c < GC; ++c) { bur += br[c] * u[c]; bui += bi[c] * u[c]; }
                const float nsr = lam.x * sr - lam.y * si + bur, nsi = lam.x * si + lam.y * sr + bui; sr = nsr; si = nsi;
                float ymine = 0.f, umine = 0.f;
#pragma unroll
                for (int c = 0; c < GC; ++c) { const float yc = wave_sum(cr[c] * sr - ci[c] * si); if ((lane & 15) == c) { ymine = yc; umine = u[c]; } }
                if (lane < GC) zbuf[row * DSSM + g * GC + lane] = f2bf(gelu_tanh(ymine + dmine * umine));
            }
        }
    #endif
    }
#if FAST_S5
    GRID_BAR(2, 3);
    if (IN(3)) {
        for (int un = (int)blockIdx.x; un < 256; un += (int)gridDim.x)
            s5::run<true>(un, qkvu, bbt, cmt, lamb, lamL, sse, args.in[11], zbuf, ldsp);
    }
#endif

    GRID_BAR(3, 4);
#if FAST_P4
    if (IN(4)) {
        pg8::DenseSched S; S.so.init(M, DSSM, (int)gridDim.x, (int)blockIdx.x); S.A = (const char*)zbuf; S.B = (const char*)WgluT; S.astep = (size_t)256 * DSSM * 2; S.bstep = (size_t)256 * DSSM * 2;
        S.nfull = 0;
        pg8::EpiGlu E{zbuf, zg, args.in[14]};
        pg8::gemm_phase<pg8::EpiGlu, pg8::DenseSched, false, true>(ldsp, DSSM, DSSM, DSSM, S, E, nullptr);
    }
#else
    if (IN(4)) {
        PH_IDX
        const float* bgl = args.in[14];
        naive_gemm(zbuf, DSSM, WgluT, DSSM, M, DSSM, DSSM, [&](int m, int n, float acc) {
            zg[(size_t)m * DSSM + n] = f2bf(bf2f(zbuf[(size_t)m * DSSM + n]) * sigmoidf_(acc + bgl[n])); }, gt, NT);
    }
#endif
    GRID_BAR(4, 5);
#if FAST_P5
    if (IN(5)) {
        pg8::BranchSched S; S.so.init(M, D, (int)gridDim.x, (int)blockIdx.x); S.A1 = (const char*)attn; S.B1 = (const char*)WaT; S.A2 = (const char*)zg; S.B2 = (const char*)WsT;
        pg8::EpiBranch2 E{gates, merged};
        pg8::gemm_phase<pg8::EpiBranch2, pg8::BranchSched, false, false, true>(ldsp, DSSM, DSSM, DSSM, S, E, nullptr);
    }
#else
    if (IN(5)) {
        PH_IDX
        for (long idx = gt; idx < (long)M * D; idx += NT) {
            const int m = (int)(idx / D), n = (int)(idx % D);
            const u32x4* a1 = (const u32x4*)(attn + (size_t)m * DATT); const u32x4* b1 = (const u32x4*)(WaT + (size_t)n * DATT);
            const u32x4* a2 = (const u32x4*)(zg + (size_t)m * DSSM); const u32x4* b2 = (const u32x4*)(WsT + (size_t)n * DSSM);
            float s1 = 0.f, s2 = 0.f;
#pragma unroll 4
            for (int k8 = 0; k8 < DATT / 8; ++k8) { s1 += dot8(a1[k8], b1[k8]); s2 += dot8(a2[k8], b2[k8]); }
            const float ga = bf2f(gates[(size_t)m * GATEC + n]), gs = bf2f(gates[(size_t)m * GATEC + D + n]);
            merged[idx] = f2bf(ga * s1 + gs * s2);
        }
    }
#endif
    GRID_BAR(5, 6);
#if FAST_P6
    if (IN(6)) {
        pg8::DenseSched S; S.so.init(M, D, (int)gridDim.x, (int)blockIdx.x); S.A = (const char*)merged; S.B = (const char*)WoutT; S.astep = (size_t)256 * D * 2; S.bstep = (size_t)256 * D * 2;
        pg8::EpiDelta E{delta};
        pg8::gemm_phase<pg8::EpiDelta, pg8::DenseSched, false>(ldsp, D, D, D, S, E, nullptr);
    }
#else
    if (IN(6)) {
        PH_IDX
        naive_gemm(merged, D, WoutT, D, M, D, D, [&](int m, int n, float acc) { out[(size_t)m * D + n] = x[(size_t)m * D + n] + acc; }, gt, NT);
    }
#endif
    GRID_BAR(6, 7);
#if FAST_P7
    if (IN(7)) {
        typedef short bf16x8_ __attribute__((ext_vector_type(8)));
        const int tid = threadIdx.x, lane = tid & 63, wave = __builtin_amdgcn_readfirstlane(tid >> 6), row = lane & 15, kg = lane >> 4;
        const float* g2 = args.in[18]; const float* brg = args.in[20]; const float* bre = args.in[22];
        LAS float* PL = (LAS float*)ldsp;
        LAS float* SSP = PL + 8 * 64 * 52;
        LAS float* RL = SSP + 8 * 4 * 64;
        LAS int* cntL = (LAS int*)(RL + 64 * 40); LAS int* baseL = cntL + 32;
        if (tid < NE) cntL[tid] = 0;
        for (int tg = (int)blockIdx.x; tg < M / 64; tg += (int)gridDim.x) {
#pragma unroll 1
            for (int half = 0; half < 2; ++half) {
                bf16x8_ wh[2][3], wl[2][3]; f32x4 ga[2], gb[2];
                const int kb = 128 * wave + 64 * half + 8 * kg;
#pragma unroll
                for (int s = 0; s < 2; ++s) { ga[s] = *(const f32x4*)(g2 + kb + 32 * s); gb[s] = *(const f32x4*)(g2 + kb + 32 * s + 4);
#pragma unroll
                    for (int nt = 0; nt < 3; ++nt) { const size_t wo = (size_t)(nt * 16 + row) * D + kb + 32 * s; wh[s][nt] = __builtin_bit_cast(bf16x8_, *(const u32x4*)(rwh + wo)); wl[s][nt] = __builtin_bit_cast(bf16x8_, *(const u32x4*)(rwl + wo)); } }
#pragma unroll 1
                for (int tile = 0; tile < 4; ++tile) {
                    const int m = tg * 64 + tile * 16 + row;
                    const float* xr = x + (size_t)m * D + kb; const bf16* dr = delta + (size_t)m * D + kb;
                    f32x4 xa[2], xb[2]; u32x4 dd[2];
#pragma unroll
                    for (int s = 0; s < 2; ++s) { xa[s] = *(const f32x4*)(xr + 32 * s); xb[s] = *(const f32x4*)(xr + 32 * s + 4); dd[s] = *(const u32x4*)(dr + 32 * s); }
                    LAS float* pl = PL + ((wave * 64) + tile * 16 + 4 * kg) * 52 + row;
                    f32x4 acc[3]; float ss = 0.f;
                    if (half) { ss = SSP[(wave * 4 + tile) * 64 + lane];
#pragma unroll
                        for (int nt = 0; nt < 3; ++nt)
#pragma unroll
                            for (int r = 0; r < 4; ++r) acc[nt][r] = pl[r * 52 + nt * 16]; }
                    else { acc[0] = (f32x4){0.f, 0.f, 0.f, 0.f}; acc[1] = acc[0]; acc[2] = acc[0]; }
#pragma unroll
                    for (int s = 0; s < 2; ++s) {
                        const f32x4 va = xa[s] + pg8::bflo4(dd[s].x, dd[s].y), vb = xb[s] + pg8::bflo4(dd[s].z, dd[s].w);
                        ss += va[0] * va[0] + va[1] * va[1] + va[2] * va[2] + va[3] * va[3] + vb[0] * vb[0] + vb[1] * vb[1] + vb[2] * vb[2] + vb[3] * vb[3];
                        const f32x4 ha = va * ga[s], hb = vb * gb[s];
                        u32x4 hw; hw.x = pg8::cvt_pk_bf16(ha[0], ha[1]); hw.y = pg8::cvt_pk_bf16(ha[2], ha[3]); hw.z = pg8::cvt_pk_bf16(hb[0], hb[1]); hw.w = pg8::cvt_pk_bf16(hb[2], hb[3]);
                        { u32x4 xw; xw.x = pg8::cvt_pk_bf16(va[0], va[1]); xw.y = pg8::cvt_pk_bf16(va[2], va[3]); xw.z = pg8::cvt_pk_bf16(vb[0], vb[1]); xw.w = pg8::cvt_pk_bf16(vb[2], vb[3]);
                          *(u32x4*)(h2u + (size_t)m * D + kb + 32 * s) = xw; }
                        u32x4 lw; lw.x = pg8::cvt_pk_bf16(ha[0] - __uint_as_float(hw.x << 16), ha[1] - __uint_as_float(hw.x & 0xffff0000u)); lw.y = pg8::cvt_pk_bf16(ha[2] - __uint_as_float(hw.y << 16), ha[3] - __uint_as_float(hw.y & 0xffff0000u));
                        lw.z = pg8::cvt_pk_bf16(hb[0] - __uint_as_float(hw.z << 16), hb[1] - __uint_as_float(hw.z & 0xffff0000u)); lw.w = pg8::cvt_pk_bf16(hb[2] - __uint_as_float(hw.w << 16), hb[3] - __uint_as_float(hw.w & 0xffff0000u));
                        const bf16x8_ ahi = __builtin_bit_cast(bf16x8_, hw), alo = __builtin_bit_cast(bf16x8_, lw);
#pragma unroll
                        for (int nt = 0; nt < 3; ++nt) {
                            acc[nt] = __builtin_amdgcn_mfma_f32_16x16x32_bf16(ahi, wh[s][nt], acc[nt], 0, 0, 0); mfma_keep(ahi, wh[s][nt], acc[nt][0]);
                            acc[nt] = __builtin_amdgcn_mfma_f32_16x16x32_bf16(alo, wh[s][nt], acc[nt], 0, 0, 0); mfma_keep(alo, wh[s][nt], acc[nt][0]);
                            acc[nt] = __builtin_amdgcn_mfma_f32_16x16x32_bf16(ahi, wl[s][nt], acc[nt], 0, 0, 0); mfma_keep(ahi, wl[s][nt], acc[nt][0]); }
                    }
                    SSP[(wave * 4 + tile) * 64 + lane] = ss;
#pragma unroll
                    for (int nt = 0; nt < 3; ++nt)
#pragma unroll
                        for (int r = 0; r < 4; ++r) pl[r * 52 + nt * 16] = acc[nt][r];
                }
            }
            __syncthreads();
#pragma unroll 1
            for (int idx = tid; idx < 64 * 37; idx += NTHREADS) { const int tok = idx / 37, i = idx - tok * 37; float sacc = 0.f;
                if (i < 36) {
#pragma unroll
                    for (int w8 = 0; w8 < 8; ++w8) sacc += PL[(w8 * 64 + tok) * 52 + i]; }
                else {
#pragma unroll
                    for (int w8 = 0; w8 < 8; ++w8)
#pragma unroll
                        for (int q4 = 0; q4 < 4; ++q4) sacc += SSP[(w8 * 4 + (tok >> 4)) * 64 + q4 * 16 + (tok & 15)]; }
                RL[tok * 40 + i] = sacc; }
            __syncthreads();
            int tq = (int)threadIdx.x; asm volatile("" : "+v"(tq));
            const bool router_lane = tq < 64; const int mt = tg * 64 + (tq & 63);
            int ex0 = 0, ex1 = 0, rk0 = 0, rk1 = 0; float w0 = 0.f, w1 = 0.f, inv = 0.f;
            if (router_lane) {
                const int tok = tq;
                inv = 1.f / sqrtf(RL[tok * 40 + 36] * (1.f / D) + EPS);
                float lg[36];
#pragma unroll
                for (int i = 0; i < 36; ++i) lg[i] = RL[tok * 40 + i] * inv;
                float gl[4];
#pragma unroll
                for (int i = 0; i < 4; ++i) gl[i] = lg[i] + brg[i];
                int gi = 0; float gm = gl[0];
#pragma unroll
                for (int i = 1; i < 4; ++i) if (gl[i] > gm) { gm = gl[i]; gi = i; }
                float gsum = 0.f;
#pragma unroll
                for (int i = 0; i < 4; ++i) gsum += __expf(gl[i] - gm);
                const float group_p = 1.f / gsum;
                float sel[8];
#pragma unroll
                for (int i = 0; i < 8; ++i) { float sv = 0.f;
#pragma unroll
                    for (int q = 0; q < 4; ++q) if (gi == q) sv = lg[4 + 8 * q + i] + bre[8 * q + i];
                    sel[i] = sv; }
                int i0 = 0; float m0 = sel[0];
#pragma unroll
                for (int i = 1; i < 8; ++i) if (sel[i] > m0) { m0 = sel[i]; i0 = i; }
                int i1 = -1; float m1 = -3.0e38f;
#pragma unroll
                for (int i = 0; i < 8; ++i) if (i != i0 && sel[i] > m1) { m1 = sel[i]; i1 = i; }
                const float e1 = __expf(m1 - m0);
                w0 = group_p / (1.f + e1); w1 = group_p * e1 / (1.f + e1);
                ex0 = gi * EPG + i0; ex1 = gi * EPG + i1;
                rk0 = __hip_atomic_fetch_add(&cntL[ex0], 1, __ATOMIC_RELAXED, __HIP_MEMORY_SCOPE_WORKGROUP); rk1 = __hip_atomic_fetch_add(&cntL[ex1], 1, __ATOMIC_RELAXED, __HIP_MEMORY_SCOPE_WORKGROUP);
            }
            __syncthreads();
            if (tq < NE) { const int c = cntL[tq]; baseL[tq] = c ? (int)atomicAdd(&ecnt[64 * tq], (unsigned)c) : 0; cntL[tq] = 0; }
            __syncthreads();
            if (router_lane) {
                const int sl0 = baseL[ex0] + rk0, sl1 = baseL[ex1] + rk1;
                lists[(size_t)ex0 * M + sl0] = make_int2(2 * mt, __float_as_int(inv)); lists[(size_t)ex1 * M + sl1] = make_int2(2 * mt + 1, __float_as_int(inv));
                tok_e[2 * mt] = ex0; tok_e[2 * mt + 1] = ex1; tok_slot[2 * mt] = sl0; tok_slot[2 * mt + 1] = sl1; tok_w[2 * mt] = w0; tok_w[2 * mt + 1] = w1; tok_inv[mt] = inv;
            }
        }
    }
#else
    if (IN(7)) {
        PH_IDX
        const float* g2 = args.in[18]; const float* wrg = args.in[19]; const float* brg = args.in[20]; const float* wre = args.in[21]; const float* bre = args.in[22];
        for (int m = gw; m < M; m += NW) {
            const float* xr = out + (size_t)m * D; float ss = 0.f;
#pragma unroll
            for (int j = 0; j < 4; ++j) { const f32x4 t = *(const f32x4*)(xr + 256 * j + 4 * lane); ss += t[0] * t[0] + t[1] * t[1] + t[2] * t[2] + t[3] * t[3]; }
            const float inv = 1.f / sqrtf(wave_sum(ss) * (1.f / D) + EPS);
            float lg[36];
#pragma unroll
            for (int i = 0; i < 36; ++i) lg[i] = 0.f;
#pragma unroll 1
            for (int kk = 0; kk < 16; ++kk) { const int k = 256 * (kk >> 2) + 4 * lane + (kk & 3); const float hv = xr[k] * g2[k]; h2u[(size_t)m * D + k] = f2bf(hv); const float hn = hv * inv;
                const f32x4 w4 = *(const f32x4*)(wrg + (size_t)k * NEG); lg[0] += hn * w4[0]; lg[1] += hn * w4[1]; lg[2] += hn * w4[2]; lg[3] += hn * w4[3];
#pragma unroll
                for (int q = 0; q < 8; ++q) { const f32x4 w = *(const f32x4*)(wre + (size_t)k * NE + 4 * q); lg[4 + 4 * q] += hn * w[0]; lg[5 + 4 * q] += hn * w[1]; lg[6 + 4 * q] += hn * w[2]; lg[7 + 4 * q] += hn * w[3]; } }
#pragma unroll
            for (int i = 0; i < 36; ++i) lg[i] = wave_sum(lg[i]);
            float gl[4];
#pragma unroll
            for (int i = 0; i < 4; ++i) gl[i] = lg[i] + brg[i];
            int gi = 0; float gm = gl[0];
#pragma unroll
            for (int i = 1; i < 4; ++i) if (gl[i] > gm) { gm = gl[i]; gi = i; }
            float gsum = 0.f;
#pragma unroll
            for (int i = 0; i < 4; ++i) gsum += __expf(gl[i] - gm);
            const float group_p = 1.f / gsum;
            float sel[8];
#pragma unroll
            for (int i = 0; i < 8; ++i) { float s = 0.f;
#pragma unroll
                for (int q = 0; q < 4; ++q) if (gi == q) s = lg[4 + 8 * q + i] + bre[8 * q + i];
                sel[i] = s; }
            int i0 = 0; float m0 = sel[0];
#pragma unroll
            for (int i = 1; i < 8; ++i) if (sel[i] > m0) { m0 = sel[i]; i0 = i; }
            int i1 = -1; float m1 = -3.0e38f;
#pragma unroll
            for (int i = 0; i < 8; ++i) if (i != i0 && sel[i] > m1) { m1 = sel[i]; i1 = i; }
            const float e1 = __expf(m1 - m0);
            const float w0 = group_p / (1.f + e1), w1 = group_p * e1 / (1.f + e1);
            if (lane == 0) {
                const int ex0 = gi * EPG + i0, ex1 = gi * EPG + i1;
                const int sl0 = (int)atomicAdd(&ecnt[64 * ex0], 1u), sl1 = (int)atomicAdd(&ecnt[64 * ex1], 1u);
                lists[(size_t)ex0 * M + sl0] = make_int2(2 * m, __float_as_int(inv)); lists[(size_t)ex1 * M + sl1] = make_int2(2 * m + 1, __float_as_int(inv));
                tok_e[2 * m] = ex0; tok_e[2 * m + 1] = ex1; tok_slot[2 * m] = sl0; tok_slot[2 * m + 1] = sl1; tok_w[2 * m] = w0; tok_w[2 * m + 1] = w1; tok_inv[m] = inv;
            }
        }
    }
#endif
    GRID_BAR(7, 8);
#if FAST_MOE
#define MOE_SETUP(PH8) \
        const int tid = threadIdx.x; \
        LAS int* ttab = (LAS int*)(ldsp + LDS_TILETAB); LAS int* cntl = (LAS int*)(ldsp + LDS_MISC); LAS int* rbase = (LAS int*)(ldsp + LDS_MISC + 256); LAS int* rowtab = (LAS int*)(ldsp + LDS_ROWTAB); \
        __syncthreads(); \
        if (tid < NE) cntl[tid] = (int)ecnt[64 * tid]; \
        __syncthreads(); \
        if (tid < 33) { int s = 0; for (int q = 0; q < tid; ++q) s += cntl[q]; rbase[tid] = s; } \
        if (tid >= 64 && tid < 64 + NE) { const int q = tid - 64; const int c = cntl[q], nf = c >> 8, rem_ = c & 255; int fb = 0, tot = 0, rank = 0, nrag = 0; \
            for (int q2 = 0; q2 < NE; ++q2) { const int c2 = cntl[q2], nf2 = c2 >> 8, rem2 = c2 & 255; tot += nf2; if (q2 < q) fb += nf2; \
                if (rem2 > 0) { ++nrag; if (rem2 > rem_ || (rem2 == rem_ && q2 < q)) ++rank; } } \
            for (int r_ = 0; r_ < nf; ++r_) ttab[fb + r_] = (q << 8) | r_; \
            if (rem_) ttab[tot + rank] = (q << 8) | nf; \
            if (q == 0) ttab[160] = tot + nrag; } \
        __syncthreads(); \
        pg8::MoeSched S; S.tpre = ttab; S.rbase = rbase; S.U = 4 * ttab[160]; S.G = (int)gridDim.x; S.c = (int)blockIdx.x; \
        if (PH8) { S.A = (const char*)h2u; S.B = (const char*)WguT; S.bstepE = (size_t)1024 * D * 2; S.bstepN = (size_t)256 * D * 2; S.arow = 0; S.gather = true; } \
        else { S.A = (const char*)act; S.B = (const char*)WdT; S.bstepE = (size_t)D * DFF * 2; S.bstepN = (size_t)256 * DFF * 2; S.arow = (size_t)DFF * 2; S.gather = false; } \
        { const int hf_ = tid >> 8, r_ = tid & 255; pg8::Unit ua_, ub_; const bool ha_ = S.next(hf_, ua_), hb_ = S.next(2 + hf_, ub_);     \
          int ea_ = 0, eb_ = 0; float va_ = 0.f, vb_ = 0.f; int2 la_ = make_int2(0, 0), lb_ = la_; \
          if (ha_) la_ = lists[(size_t)ua_.aux * M + ua_.rt * 256 + (r_ < ua_.nrows ? r_ : 0)]; \
          if (hb_) lb_ = lists[(size_t)ub_.aux * M + ub_.rt * 256 + (r_ < ub_.nrows ? r_ : 0)]; \
          ea_ = la_.x; eb_ = lb_.x; \
          if (ha_) va_ = (PH8) ? __int_as_float(la_.y) : tok_w[ea_];            \
          if (hb_) vb_ = (PH8) ? __int_as_float(lb_.y) : tok_w[eb_]; \
          if (ha_) { rowtab[2 * (hf_ * 256 + r_)] = (PH8) ? (ea_ >> 1) : ea_; rowtab[2 * (hf_ * 256 + r_) + 1] = __float_as_int(va_); } \
          if (hb_) { rowtab[2 * ((2 + hf_) * 256 + r_)] = (PH8) ? (eb_ >> 1) : eb_; rowtab[2 * ((2 + hf_) * 256 + r_) + 1] = __float_as_int(vb_); } } \
        __syncthreads();
    if (IN(8)) { MOE_SETUP(true)
        pg8::EpiAct E{act, rowtab}; pg8::gemm_phase<pg8::EpiAct, pg8::MoeSched, true, true>(ldsp, D, D, D, S, E, rowtab);
        {
            int tq = (int)threadIdx.x; asm volatile("" : "+v"(tq));
            const int lane = tq & 63, wave = __builtin_amdgcn_readfirstlane(tq >> 6);
            const int ntl = ttab[160], c = (int)blockIdx.x;
            int nidleq = 64 * ((ntl + 63) / 64) - ntl, rank = c, npart = (int)gridDim.x;
            if ((int)gridDim.x == 256 && nidleq > 0) { const int q = (c & 7) * 8 + (c >> 5); rank = (q - (64 - nidleq)) * 4 + ((c >> 3) & 3); npart = 4 * nidleq; if (q < 64 - nidleq) rank = -1; }
            if (rank >= 0) { const int first = CV_ALL - CV_P8X + rank * NWAVES + wave, stride = npart * NWAVES;
                cv_run(first, stride, (CV_ALL - first + stride - 1) / stride, (LAS float*)(ldsp + wave * 8448), lane); }
        } }
    XbTicket tk89; tk89.mode = 0u; tk89.val = 0u;
    if (BOTH(8, 9)) tk89 = xcd_barrier_arrive(gbar);
    if (IN(9)) { MOE_SETUP(false)
        if (BOTH(8, 9)) xcd_barrier_wait(gbar, tk89);
        pg8::EpiDown E{contrib, rowtab}; pg8::gemm_phase<pg8::EpiDown, pg8::MoeSched, false, true>(ldsp, DFF, DFF, DFF, S, E, rowtab); }
    else if (BOTH(8, 9)) xcd_barrier_wait(gbar, tk89);
#else
    if (IN(8)) {
        PH_IDX
        for (long idx = gt; idx < (long)2 * M * DFF; idx += NT) {
            const int pos = (int)(idx / DFF), j = (int)(idx % DFF);
            int e = 0, base = 0;
            for (int q = 0; q < NE; ++q) { const int c = (int)ecnt[64 * q]; if (pos >= base + c) { base += c; e = q + 1; } else break; }
            const int ent = lists[(size_t)e * M + (pos - base)].x; const int tok = ent >> 1;
            const float inv = tok_inv[tok];
            const u32x4* a = (const u32x4*)(h2u + (size_t)tok * D);
            const int np = 256 * (j >> 7) + (j & 127);
            const u32x4* bgp = (const u32x4*)(WguT + ((size_t)e * 1024 + np) * D); const u32x4* bup = (const u32x4*)(WguT + ((size_t)e * 1024 + np + 128) * D);
            float sg = 0.f, su = 0.f;
#pragma unroll 4
            for (int k8 = 0; k8 < D / 8; ++k8) { const u32x4 av = a[k8]; sg += dot8(av, bgp[k8]); su += dot8(av, bup[k8]); }
            sg *= inv; su *= inv;
            act[(size_t)pos * DFF + j] = f2bf(sg * sigmoidf_(sg) * su);
        }
    }
    GRID_BAR(8, 9);
    if (IN(9)) {
        PH_IDX
        for (long idx = gt; idx < (long)2 * M * D; idx += NT) {
            const int pos = (int)(idx / D), n = (int)(idx % D);
            int e = 0, base = 0;
            for (int q = 0; q < NE; ++q) { const int c = (int)ecnt[64 * q]; if (pos >= base + c) { base += c; e = q + 1; } else break; }
            const int ent = lists[(size_t)e * M + (pos - base)].x; const int tok = ent >> 1, kk = ent & 1;
            const u32x4* a = (const u32x4*)(act + (size_t)pos * DFF); const u32x4* b = (const u32x4*)(WdT + ((size_t)e * D + n) * DFF);
            float s = 0.f;
#pragma unroll 4
            for (int k8 = 0; k8 < DFF / 8; ++k8) s += dot8(a[k8], b[k8]);
            contrib[((size_t)kk * M + tok) * D + n] = f2bf(s * tok_w[2 * tok + kk]);
        }
    }
#endif
    GRID_BAR(9, 10);
#if FAST_P10
    if (IN(10)) {
        PH_IDX
        const float* gf = args.in[26]; f32x4 gv[4];
#pragma unroll
        for (int j = 0; j < 4; ++j) gv[j] = *(const f32x4*)(gf + 256 * j + 4 * lane);
        typedef unsigned u32x2_ __attribute__((ext_vector_type(2)));
        u32x2_ xn[4], c0n[4], c1n[4];
#define P10_LOAD(mm) do { _Pragma("unroll") for (int j = 0; j < 4; ++j) { const size_t off = (size_t)(mm) * D + 256 * j + 4 * lane; \
            xn[j] = *(const u32x2_*)(h2u + off); c0n[j] = *(const u32x2_*)(contrib + off); c1n[j] = *(const u32x2_*)(contrib + (size_t)M * D + off); } } while (0)
        if (gw < M) P10_LOAD(gw);
#pragma unroll 1
        for (int m = gw; m < M; m += NW) {
            f32x4 v[4]; float ss = 0.f;
#pragma unroll
            for (int j = 0; j < 4; ++j) v[j] = pg8::bflo4(xn[j].x, xn[j].y) + pg8::bflo4(c0n[j].x, c0n[j].y) + pg8::bflo4(c1n[j].x, c1n[j].y);
            if (m + NW < M) P10_LOAD(m + NW);
#pragma unroll
            for (int j = 0; j < 4; ++j) ss += v[j][0] * v[j][0] + v[j][1] * v[j][1] + v[j][2] * v[j][2] + v[j][3] * v[j][3];
            const float inv = 1.f / sqrtf(wave_sum(ss) * (1.f / D) + EPS);
#pragma unroll
            for (int j = 0; j < 4; ++j) *(f32x4*)(out + (size_t)m * D + 256 * j + 4 * lane) = v[j] * inv * gv[j];
        }
    }
#else
    if (IN(10)) {
        PH_IDX
        const float* gf = args.in[26];
        for (int m = gw; m < M; m += NW) {
            float v[16]; float ss = 0.f;
#pragma unroll
            for (int j = 0; j < 4; ++j)
#pragma unroll
                for (int i = 0; i < 4; ++i) { const int k = 256 * j + 4 * lane + i; const float t = out[(size_t)m * D + k] + bf2f(contrib[(size_t)m * D + k]) + bf2f(contrib[((size_t)M + m) * D + k]); v[4 * j + i] = t; ss += t * t; }
            const float inv = 1.f / sqrtf(wave_sum(ss) * (1.f / D) + EPS);
#pragma unroll
            for (int j = 0; j < 4; ++j)
#pragma unroll
                for (int i = 0; i < 4; ++i) { const int k = 256 * j + 4 * lane + i; out[(size_t)m * D + k] = v[4 * j + i] * inv * gf[k]; }
        }
    }
#endif
#undef IN
}

extern "C" void kernel_launch(void* const* d_in, const int* in_sizes, int n_in, void* d_out, int out_size, void* d_ws, size_t ws_size, hipStream_t stream) {
    static int grid = 0;
    if (grid == 0) {
        if (n_in != 27 || out_size != M * D || ws_size < WS_END) { fprintf(stderr, "kernel_launch: unexpected shapes (n_in %d out %d ws %zu)\n", n_in, out_size, ws_size); grid = -1; return; }
        int dev = 0, cus = 0;
        if (hipGetDevice(&dev) != hipSuccess || hipDeviceGetAttribute(&cus, hipDeviceAttributeMultiprocessorCount, dev) != hipSuccess) { grid = -1; return; }
        if (hipFuncSetAttribute((const void*)fwd, hipFuncAttributeMaxDynamicSharedMemorySize, LDS_BYTES) != hipSuccess) { grid = -1; return; }
        grid = cus;
    }
    if (grid < 0) return;
    (void)hipMemsetAsync((char*)d_ws + WS_CTL, 0, CTL_ZERO_BYTES, stream);
    Args a{};
    for (int i = 0; i < 27; ++i) a.in[i] = (const float*)d_in[i];
    a.out = (float*)d_out; a.ws = (unsigned char*)d_ws;
#if defined(PROBE_PH)
    a.ph_lo = 0; a.ph_hi = PROBE_PH + 1;
    hipLaunchKernelGGL(fwd, dim3(grid), dim3(NTHREADS), LDS_BYTES, stream, a);
    (void)hipMemsetAsync((char*)d_ws + WS_CTL + CW_BAR * 4, 0, XCD_BAR_WORDS * 4, stream);
    (void)hipMemsetAsync((char*)d_ws + WS_CTL + CW_CNT * 4, 0, 2048 * 4, stream);
    a.ph_lo = PROBE_PH; a.ph_hi = NPH;
    hipLaunchKernelGGL(fwd, dim3(grid), dim3(NTHREADS), LDS_BYTES, stream, a);
#elif MK_N_LAUNCHES == 1
    a.ph_lo = 0; a.ph_hi = NPH;
    hipLaunchKernelGGL(fwd, dim3(grid), dim3(NTHREADS), LDS_BYTES, stream, a);
#else
    for (int p = 0; p < NPH; ++p) {
        a.ph_lo = p; a.ph_hi = p + 1;
        hipLaunchKernelGGL(fwd, dim3(grid), dim3(NTHREADS), LDS_BYTES, stream, a);
    }
#endif
}
```

```cpp
#include <hip/hip_runtime.h>
#include <cstdio>
#include <cstdint>

constexpr int BATCH = 2, SEQ = 8192, D = 1024, M = BATCH * SEQ;
constexpr int DSSM = 512, NG = 32, GC = 16, PS = 64;
constexpr int HD = 64, NH = 8, NKV = 2, DATT = 512, WIN = 128;
constexpr int INC = 3328, GATEC = 2048;
constexpr int NEG = 4, EPG = 8, NE = 32, DFF = 512;
constexpr int QKVU_LD = 1280;
constexpr int QOFF = 0, KOFF = 512, VOFF = 640, UOFF = 768;
constexpr float EPS = 1e-6f;
constexpr int LSUB = 128;
constexpr int NSUB = SEQ / LSUB;

constexpr size_t MiB = 1u << 20;
constexpr size_t WS_CTL = 0, CTL_ZERO_BYTES = 1 * MiB;
constexpr size_t WS_PAR = 1 * MiB;
constexpr size_t WS_SSE = 2 * MiB;
constexpr size_t WS_LIST = 4 * MiB;
constexpr size_t WS_TOK = 6 * MiB;
constexpr size_t WS_WIN = 8 * MiB;
constexpr size_t WS_WGLU = 15 * MiB;
constexpr size_t WS_WA = 16 * MiB;
constexpr size_t WS_WS = 17 * MiB;
constexpr size_t WS_WOUT = 18 * MiB;
constexpr size_t WS_WGU = 20 * MiB;
constexpr size_t WS_WD = 84 * MiB;
constexpr size_t WS_R1 = 116 * MiB;
constexpr size_t WS_GATES = 149 * MiB;
constexpr size_t WS_QKVU = 213 * MiB;
constexpr size_t WS_END = 253 * MiB;
constexpr size_t DO_ATTN = 0, DO_Z = 16 * MiB, DO_ZG = 32 * MiB;

constexpr int CW_TMO = 0;
constexpr int CW_CNT = 1024;
constexpr int CW_BAR = 4096;
constexpr int CW_ROWSS = 16384;

constexpr size_t PAR_LAMB = 0;
constexpr size_t PAR_LAML = 16384;
constexpr size_t PAR_BBAR = 32768;
constexpr size_t PAR_BBT = PAR_BBAR + 32 * 64 * 16 * 8;
constexpr size_t PAR_CMT = PAR_BBT + 32 * 4 * 64 * 16;
constexpr size_t PAR_END = PAR_CMT + 32 * 4 * 64 * 16;
constexpr size_t PAR_RWH = PAR_END;
constexpr size_t PAR_RWL = PAR_RWH + 48 * 1024 * 2;
constexpr size_t PAR_END2 = PAR_RWL + 48 * 1024 * 2;
static_assert(PAR_END2 <= MiB, "PAR region");

constexpr size_t TOK_E = 0;
constexpr size_t TOK_SLOT = 128 * 1024;
constexpr size_t TOK_W = 256 * 1024;
constexpr size_t TOK_INV = 384 * 1024;

constexpr int NWAVES = 8;
constexpr int NTHREADS = NWAVES * 64;
constexpr int LDS_BYTES = 147456;
constexpr int LDS_MISC = 131072;
constexpr int LDS_TILETAB = LDS_MISC + 640;
constexpr int LDS_ROWTAB = LDS_MISC + 2048;
constexpr int LDS_BARW = LDS_MISC + 512;
constexpr int NPH = 11;
#ifndef CV_STREAM_J
#define CV_STREAM_J 22
#endif
#ifndef CV_NGW
#define CV_NGW 208
#endif
#ifndef CV_TAIL_J
#define CV_TAIL_J 0
#endif
#ifndef CV_P8X
#define CV_P8X 8192
#endif
#ifndef CV_P0X
#define CV_P0X 9088
#endif
#ifndef FAST_P1
#define FAST_P1 1
#endif
#ifndef FAST_P4
#define FAST_P4 1
#endif
#ifndef FAST_P5
#define FAST_P5 1
#endif
#ifndef FAST_P6
#define FAST_P6 1
#endif
#ifndef FAST_P0
#define FAST_P0 1
#endif
#ifndef FAST_P10
#define FAST_P10 1
#endif
#ifndef FAST_ATT
#define FAST_ATT 1
#endif
#ifndef FAST_P7
#define FAST_P7 1
#endif
#ifndef FAST_S5
#define FAST_S5 1
#endif
#ifndef FAST_MOE
#define FAST_MOE 1
#endif
#ifndef MK_N_LAUNCHES
#define MK_N_LAUNCHES 1
#endif

typedef unsigned short bf16;
typedef float f32x4 __attribute__((ext_vector_type(4)));
typedef unsigned u32x4 __attribute__((ext_vector_type(4)));


typedef short kbf16x8 __attribute__((ext_vector_type(8)));
__device__ __forceinline__ void mfma_keep(kbf16x8 a, kbf16x8 b, float r0) {
    const u32x4 au = __builtin_bit_cast(u32x4, a), bu = __builtin_bit_cast(u32x4, b);
    asm volatile("" :: "v"(au.x), "v"(au.y), "v"(au.z), "v"(au.w), "v"(bu.x), "v"(bu.y), "v"(bu.z), "v"(bu.w), "v"(r0));
}
__device__ __forceinline__ float opq(float x) { asm volatile("" : "+v"(x)); return x; }
__device__ __forceinline__ float bf2f(bf16 b) { return __uint_as_float(((unsigned)b) << 16); }
__device__ __forceinline__ bf16 f2bf(float f) { unsigned u = __float_as_uint(f); return (bf16)((u + 0x7fffu + ((u >> 16) & 1u)) >> 16); }
__device__ __forceinline__ float wave_sum(float v) {
#pragma unroll
    for (int o = 1; o < 64; o <<= 1) v += __shfl_xor(v, o);
    return v;
}
__device__ __forceinline__ float wave_max(float v) {
#pragma unroll
    for (int o = 1; o < 64; o <<= 1) v = fmaxf(v, __shfl_xor(v, o));
    return v;
}
__device__ __forceinline__ float dot8(u32x4 a, u32x4 b) {
    float s = 0.f;
#pragma unroll
    for (int j = 0; j < 4; ++j) {
        s += __uint_as_float(a[j] << 16) * __uint_as_float(b[j] << 16);
        s += __uint_as_float(a[j] & 0xffff0000u) * __uint_as_float(b[j] & 0xffff0000u);
    }
    return s;
}
__device__ __forceinline__ float sigmoidf_(float x) { return 1.f / (1.f + __expf(-x)); }
__device__ __forceinline__ float gelu_tanh(float x) {
    const float u = 0.7978845608028654f * (x + 0.044715f * x * x * x);
    const float e = __expf(2.f * u);
    const float th = 1.f - 2.f / (e + 1.f);
    return 0.5f * x * (1.f + th);
}

__device__ __forceinline__ double dexp_(double x) {
    const double k = rint(x * 1.4426950408889634);
    const double r = fma(-k, 1.9082149292705877e-10, fma(-k, 0.6931471803691238, x));
    double p = 1.0 / 6227020800.0;
    p = fma(p, r, 1.0 / 479001600.0); p = fma(p, r, 1.0 / 39916800.0); p = fma(p, r, 1.0 / 3628800.0); p = fma(p, r, 1.0 / 362880.0);
    p = fma(p, r, 1.0 / 40320.0); p = fma(p, r, 1.0 / 5040.0); p = fma(p, r, 1.0 / 720.0); p = fma(p, r, 1.0 / 120.0);
    p = fma(p, r, 1.0 / 24.0); p = fma(p, r, 1.0 / 6.0); p = fma(p, r, 0.5); p = fma(p, r, 1.0); p = fma(p, r, 1.0);
    const long long e = (long long)k + 1023;
    return p * __longlong_as_double(e << 52);
}
__device__ __forceinline__ void dsincos_(double x, double& s, double& c) {
    const double k = rint(x * 0.6366197723675814);
    const double r = fma(-k, 6.123233995736766e-17, fma(-k, 1.5707963267948966, x));
    const double r2 = r * r;
    double sp = -1.0 / 1307674368000.0;
    sp = fma(sp, r2, 1.0 / 6227020800.0); sp = fma(sp, r2, -1.0 / 39916800.0); sp = fma(sp, r2, 1.0 / 362880.0);
    sp = fma(sp, r2, -1.0 / 5040.0); sp = fma(sp, r2, 1.0 / 120.0); sp = fma(sp, r2, -1.0 / 6.0); sp = fma(sp * r2, r, r);
    double cp = 1.0 / 20922789888000.0;
    cp = fma(cp, r2, -1.0 / 87178291200.0); cp = fma(cp, r2, 1.0 / 479001600.0); cp = fma(cp, r2, -1.0 / 3628800.0);
    cp = fma(cp, r2, 1.0 / 40320.0); cp = fma(cp, r2, -1.0 / 720.0); cp = fma(cp, r2, 1.0 / 24.0); cp = fma(cp, r2, -0.5); cp = fma(cp, r2, 1.0);
    const int q = ((int)k) & 3;
    s = (q == 0) ? sp : (q == 1) ? cp : (q == 2) ? -sp : -cp;
    c = (q == 0) ? cp : (q == 1) ? -sp : (q == 2) ? -cp : sp;
}


#define LAS __attribute__((address_space(3)))
namespace pg8 {
typedef short bf16x8 __attribute__((ext_vector_type(8)));
constexpr int BM = 256, BK = 64, HALF = 128, HTB = HALF * BK * 2, STAGE_BYTES = 8 * HTB, NXCD = 8, WGM = 8;
__device__ __forceinline__ int lds_byte(int r, int c) { const int st = (r >> 4) * 2 + (c >> 5), rr = r & 15, cc = c & 31, ob = rr * 64 + cc * 2; return st * 1024 + (ob ^ (((ob >> 9) & 1) << 5)); }
__device__ __forceinline__ void stage_rc(int b, int& R, int& C) { const int st = b / 1024, sb = b % 1024, swz = sb ^ (((sb >> 9) & 1) << 5); R = (st >> 1) * 16 + swz / 64; C = (st & 1) * 32 + (swz % 64) / 2; }
__device__ __forceinline__ int perm32(int rho) { const int n = rho >> 4, i = rho & 15; return 8 * (i >> 2) + 4 * n + (i & 3); }
typedef float f32x2_t __attribute__((ext_vector_type(2)));
typedef __bf16 bf16x2_t __attribute__((ext_vector_type(2)));
__device__ __forceinline__ unsigned cvt_pk_bf16(float lo, float hi) { const f32x2_t v = {lo, hi}; const bf16x2_t b = __builtin_convertvector(v, bf16x2_t); return __builtin_bit_cast(unsigned, b); }

struct Unit { const char* a; const char* b; int row0, col0, nrows, aux, rt; };

struct StaticOrder {
    int nM, nN, nwg, G, c;
    __device__ void init(int Mr, int N, int G_, int c_) { nM = Mr / BM; nN = N / BM; nwg = nM * nN; G = G_; c = c_; }
    __device__ bool next(int i, int& pm, int& pn) const { return at((long)i * G + c, pm, pn); }
    __device__ bool at(const long L, int& pm, int& pn) const {
        if (L >= nwg) return false;
        int wgid = (int)L; { const int q = nwg / NXCD, r = nwg % NXCD, xcd = wgid % NXCD, off = wgid / NXCD; wgid = (xcd < r ? xcd * (q + 1) : r * (q + 1) + (xcd - r) * q) + off; }
        const int nig = WGM * nN, gid = wgid / nig, fm = gid * WGM, gsz = (nM - fm) < WGM ? (nM - fm) : WGM;
        pm = fm + ((wgid % nig) % gsz); pn = (wgid % nig) / gsz; return true;
    }
};
struct DenseSched {
    StaticOrder so; const char* A; const char* B; size_t astep, bstep;
    int nfull = 1 << 30;
    __device__ bool next(int i, Unit& u) const {
        const long L = (long)i * so.G + so.c; int pm, pn; int half = -1; long Lu = L;
        if (L >= nfull) { const long hl = L - nfull; Lu = nfull + (hl >> 1); half = (int)(hl & 1); }
        if (!so.at(Lu, pm, pn)) return false;
        u.a = A + (size_t)pm * astep; u.b = B + (size_t)pn * bstep; u.row0 = pm * BM; u.col0 = pn * BM; u.nrows = BM; u.aux = 0; u.rt = 0;
        if (half >= 0) { u.nrows = HALF; if (half) { u.a += astep / 2; u.row0 += HALF; } }
        return true; }
};

template <class Epi, class Sched, bool GATHER, bool GATHER_OR_RAGGED = false, bool CARRY_ACC = false>
__device__ __forceinline__ void gemm_phase(LAS unsigned char* lds, const int K, const int lda, const int ldb, const Sched& S, const Epi& E, const LAS int* rowtab) {
    const int tid = threadIdx.x, wid = __builtin_amdgcn_readfirstlane(tid >> 6), lane = tid & 63, wr = wid >> 2, wc = wid & 3, fr = lane & 15, fq = lane >> 4;
    const int nt = K / BK;
    unsigned voffA[2][2], voffB[2];
#pragma unroll
    for (int i = 0; i < 2; ++i) { int R, C; stage_rc(tid * 16 + i * 8192, R, C); const int Rb = Epi::PERM ? ((R & ~31) + perm32(R & 31)) : R;
        voffB[i] = (unsigned)(Rb * ldb + C) * 2u;
        voffA[0][i] = (unsigned)(R * lda + C) * 2u; voffA[1][i] = (unsigned)((R + HALF) * lda + C) * 2u; }
    const size_t kstep = (size_t)(BK * 2);
    const size_t hstepB = (size_t)HALF * ldb * 2;
    const unsigned ldsw = (unsigned)wid * 1024u;
    const int aoff = lds_byte(wr * 64 + fr, fq * 8), boff = lds_byte(wc * 32 + fr, fq * 8);
#define PG8_SA(b, h) (((b) * 2 + (h)) * HTB)
#define PG8_SB(b, h) ((4 + (b) * 2 + (h)) * HTB)
#define PG8_STAGEB(bufoff, gbase) do { _Pragma("unroll") for (int _i = 0; _i < 2; ++_i) \
        __builtin_amdgcn_global_load_lds((const unsigned*)((const char*)(gbase) + voffB[_i]), (LAS unsigned*)(lds + (bufoff) + ldsw + _i * 8192), 16, 0, 0); } while (0)
#define PG8_STAGEA(bufoff, gbase, h) do { _Pragma("unroll") for (int _i = 0; _i < 2; ++_i) \
        __builtin_amdgcn_global_load_lds((const unsigned*)((const char*)(gbase) + voffA[h][_i]), (LAS unsigned*)(lds + (bufoff) + ldsw + _i * 8192), 16, 0, 0); } while (0)
#define PG8_LDA(dst, b, h) do { _Pragma("unroll") for (int m = 0; m < 4; ++m) _Pragma("unroll") for (int k = 0; k < 2; ++k) dst[m][k] = *(const LAS bf16x8*)(lds + PG8_SA(b, h) + aoff + m * 2048 + k * 1024); } while (0)
#define PG8_LDB(dst, b, h) do { _Pragma("unroll") for (int n = 0; n < 2; ++n) _Pragma("unroll") for (int k = 0; k < 2; ++k) dst[n][k] = *(const LAS bf16x8*)(lds + PG8_SB(b, h) + boff + n * 2048 + k * 1024); } while (0)
#define PG8_MMA(ai, bj, At, Bt) do { __builtin_amdgcn_s_setprio(1); _Pragma("unroll") for (int m = 0; m < 4; ++m) _Pragma("unroll") for (int n = 0; n < 2; ++n) _Pragma("unroll") for (int k = 0; k < 2; ++k) \
        acc[ai][bj][m][n] = __builtin_amdgcn_mfma_f32_16x16x32_bf16(Bt[n][k], At[m][k], acc[ai][bj][m][n], 0, 0, 0); __builtin_amdgcn_s_setprio(0); } while (0)
#define PG8_WAIT_V(n) asm volatile("s_waitcnt vmcnt(" #n ")" ::: "memory")
#define PG8_WAIT_L(n) asm volatile("s_waitcnt lgkmcnt(" #n ")" ::: "memory")
#define PG8_BAR __builtin_amdgcn_s_barrier()
#define PG8_SCHED __builtin_amdgcn_sched_barrier(0)
#define PG8_GATHER_OFFS(uidx) do { if constexpr (GATHER) { _Pragma("unroll") for (int _i = 0; _i < 2; ++_i) { int R, C; stage_rc(tid * 16 + _i * 8192, R, C); \
        voffA[0][_i] = (unsigned)(rowtab[2 * ((uidx) * 256 + R)] * lda + C) * 2u; voffA[1][_i] = (unsigned)(rowtab[2 * ((uidx) * 256 + R + HALF)] * lda + C) * 2u; } } } while (0)
    Unit cur, nxt; int ui = 0;
    if (!S.next(0, cur)) return;
    f32x4 acc[2][2][4][2];
#pragma unroll
    for (int a = 0; a < 2; ++a)
#pragma unroll
        for (int b = 0; b < 2; ++b)
#pragma unroll
            for (int m = 0; m < 4; ++m)
#pragma unroll
                for (int n = 0; n < 2; ++n) acc[a][b][m][n] = (f32x4){0.f, 0.f, 0.f, 0.f};
    bf16x8 At[4][2], B0[2][2], B1[2][2];
    const char* cA = cur.a; const char* cB = cur.b;
    PG8_GATHER_OFFS(0);
    PG8_STAGEB(PG8_SB(0, 0), cB); PG8_STAGEB(PG8_SB(0, 1), cB + hstepB); PG8_STAGEA(PG8_SA(0, 0), cA, 0); PG8_STAGEA(PG8_SA(0, 1), cA, 1);
    if (wr == 1) PG8_BAR;
    PG8_WAIT_V(2); PG8_BAR;
    PG8_STAGEB(PG8_SB(1, 0), cB + kstep); PG8_STAGEA(PG8_SA(1, 0), cA + kstep, 0); PG8_STAGEB(PG8_SB(1, 1), cB + hstepB + kstep);
    PG8_WAIT_V(6); PG8_BAR;
    for (;;) {
        const bool has_next = S.next(ui + 1, nxt);
        const bool skip1 = GATHER_OR_RAGGED && (cur.nrows <= HALF);
        const char* nA = has_next ? nxt.a : cA; const char* nB = has_next ? nxt.b : cB;
        for (int t = 0; t < nt; t += 2) {
            const bool last = (t == nt - 2);
            const char* a1 = cA + (size_t)(t + 1) * kstep;
            const char* a2 = last ? nA : cA + (size_t)(t + 2) * kstep; const char* b2 = last ? nB : cB + (size_t)(t + 2) * kstep;
            const char* a3 = a2 + kstep; const char* b3 = b2 + kstep;
            PG8_LDB(B0, 0, 0); PG8_LDB(B1, 0, 1); PG8_SCHED; PG8_LDA(At, 0, 0); PG8_STAGEA(PG8_SA(1, 1), a1, 1);
            if (GATHER && last && has_next) PG8_GATHER_OFFS(ui + 1);
            PG8_WAIT_V(8); PG8_WAIT_L(0); PG8_BAR; PG8_MMA(0, 0, At, B0); PG8_MMA(0, 1, At, B1); PG8_BAR; PG8_SCHED;
            PG8_LDA(At, 0, 1); PG8_STAGEB(PG8_SB(0, 0), b2); PG8_STAGEB(PG8_SB(0, 1), b2 + hstepB); PG8_STAGEA(PG8_SA(0, 0), a2, 0);
            PG8_WAIT_V(8); PG8_WAIT_L(0); PG8_BAR; if (!skip1) { PG8_MMA(1, 0, At, B0); PG8_MMA(1, 1, At, B1); } PG8_BAR; PG8_SCHED;
            PG8_LDB(B0, 1, 0); PG8_LDB(B1, 1, 1); PG8_SCHED; PG8_LDA(At, 1, 0); PG8_STAGEA(PG8_SA(0, 1), a2, 1);
            PG8_WAIT_V(8); PG8_WAIT_L(0); PG8_BAR; PG8_MMA(0, 0, At, B0); PG8_MMA(0, 1, At, B1); PG8_BAR; PG8_SCHED;
            PG8_LDA(At, 1, 1); PG8_STAGEB(PG8_SB(1, 0), b3); PG8_STAGEB(PG8_SB(1, 1), b3 + hstepB); PG8_STAGEA(PG8_SA(1, 0), a3, 0);
            PG8_WAIT_V(8); PG8_WAIT_L(0); PG8_BAR; if (!skip1) { PG8_MMA(1, 0, At, B0); PG8_MMA(1, 1, At, B1); } PG8_BAR; PG8_SCHED;
        }
        if (wr == 0) PG8_BAR;
        E(acc, cur, ui, wr, wc, fr, fq);
        if (!has_next) break;
        if (!(CARRY_ACC && cur.aux == 1)) {
#pragma unroll
        for (int a = 0; a < 2; ++a)
#pragma unroll
            for (int b = 0; b < 2; ++b)
#pragma unroll
                for (int m = 0; m < 4; ++m)
#pragma unroll
                    for (int n = 0; n < 2; ++n) acc[a][b][m][n] = (f32x4){0.f, 0.f, 0.f, 0.f};
        }
        cur = nxt; cA = nA; cB = nB; ++ui;
        if (wr == 1) PG8_BAR;
    }
    PG8_WAIT_V(0);
    PG8_BAR;
#undef PG8_SA
#undef PG8_SB
#undef PG8_STAGEA
#undef PG8_STAGEB
#undef PG8_LDA
#undef PG8_LDB
#undef PG8_MMA
#undef PG8_WAIT_V
#undef PG8_WAIT_L
#undef PG8_BAR
#undef PG8_SCHED
#undef PG8_GATHER_OFFS
}

__device__ __forceinline__ float sigm(float x) { return __builtin_amdgcn_rcpf(1.f + __builtin_amdgcn_exp2f(-1.4426950408889634f * x)); }
__device__ __forceinline__ f32x4 bflo4(unsigned a, unsigned b) { return (f32x4){__uint_as_float(a << 16), __uint_as_float(a & 0xffff0000u), __uint_as_float(b << 16), __uint_as_float(b & 0xffff0000u)}; }
#define EPI_LOOP_AM _Pragma("unroll") for (int ai = 0; ai < 2; ++ai) _Pragma("unroll") for (int m = 0; m < 4; ++m)
#define EPI_LOOP_AM_H(u) _Pragma("unroll") for (int ai = 0; ai < 2; ++ai) if (ai * HALF < (u).nrows) _Pragma("unroll") for (int m = 0; m < 4; ++m)

struct EpiProj {
    static constexpr bool PERM = true;
    bf16* qkvu; bf16* gates; const float* bgate;
    __device__ __forceinline__ void operator()(const f32x4 (&acc)[2][2][4][2], const Unit& u, int, int wr, int wc, int fr, int fq) const {
        const int row0 = u.row0 + wr * 64 + fr;
        if (u.col0 < QKVU_LD) {
            const int col0 = u.col0 + wc * 32 + 8 * fq;
            EPI_LOOP_AM_H(u) { bf16* rowp = qkvu + (size_t)(row0 + ai * HALF + m * 16) * QKVU_LD + col0;
#pragma unroll
                for (int bj = 0; bj < 2; ++bj) { const f32x4 v0 = acc[ai][bj][m][0], v1 = acc[ai][bj][m][1];
                    u32x4 w; w.x = cvt_pk_bf16(v0[0], v0[1]); w.y = cvt_pk_bf16(v0[2], v0[3]); w.z = cvt_pk_bf16(v1[0], v1[1]); w.w = cvt_pk_bf16(v1[2], v1[3]);
                    *(u32x4*)(rowp + bj * HALF) = w; } }
        } else {
            const int col0 = u.col0 - QKVU_LD + wc * 32 + 8 * fq;
            f32x4 bv[2][2];
#pragma unroll
            for (int bj = 0; bj < 2; ++bj)
#pragma unroll
                for (int n = 0; n < 2; ++n) bv[bj][n] = *(const f32x4*)(bgate + col0 + bj * HALF + 4 * n);
            EPI_LOOP_AM_H(u) { bf16* rowp = gates + (size_t)(row0 + ai * HALF + m * 16) * GATEC + col0;
#pragma unroll
                for (int bj = 0; bj < 2; ++bj) { const f32x4 v0 = acc[ai][bj][m][0] + bv[bj][0], v1 = acc[ai][bj][m][1] + bv[bj][1];
                    u32x4 w; w.x = cvt_pk_bf16(sigm(v0[0]), sigm(v0[1])); w.y = cvt_pk_bf16(sigm(v0[2]), sigm(v0[3])); w.z = cvt_pk_bf16(sigm(v1[0]), sigm(v1[1])); w.w = cvt_pk_bf16(sigm(v1[2]), sigm(v1[3]));
                    *(u32x4*)(rowp + bj * HALF) = w; } }
        }
    }
};
struct EpiGlu {
    static constexpr bool PERM = true;
    const bf16* z; bf16* zg; const float* bglu;
    __device__ __forceinline__ void operator()(const f32x4 (&acc)[2][2][4][2], const Unit& u, int, int wr, int wc, int fr, int fq) const {
        const int row0 = u.row0 + wr * 64 + fr, col0 = u.col0 + wc * 32 + 8 * fq;
        f32x4 bv[2][2];
#pragma unroll
        for (int bj = 0; bj < 2; ++bj)
#pragma unroll
            for (int n = 0; n < 2; ++n) bv[bj][n] = *(const f32x4*)(bglu + col0 + bj * HALF + 4 * n);
        EPI_LOOP_AM_H(u) { const size_t off = (size_t)(row0 + ai * HALF + m * 16) * DSSM + col0;
#pragma unroll
            for (int bj = 0; bj < 2; ++bj) { const u32x4 zz = *(const u32x4*)(z + off + bj * HALF); const f32x4 z0 = bflo4(zz.x, zz.y), z1 = bflo4(zz.z, zz.w);
                const f32x4 v0 = acc[ai][bj][m][0] + bv[bj][0], v1 = acc[ai][bj][m][1] + bv[bj][1];
                u32x4 w; w.x = cvt_pk_bf16(z0[0] * sigm(v0[0]), z0[1] * sigm(v0[1])); w.y = cvt_pk_bf16(z0[2] * sigm(v0[2]), z0[3] * sigm(v0[3]));
                w.z = cvt_pk_bf16(z1[0] * sigm(v1[0]), z1[1] * sigm(v1[1])); w.w = cvt_pk_bf16(z1[2] * sigm(v1[2]), z1[3] * sigm(v1[3]));
                *(u32x4*)(zg + off + bj * HALF) = w; } }
    }
};
template <bool SECOND> struct EpiBranch {
    static constexpr bool PERM = true;
    const bf16* gates; bf16* pa; bf16* merged;
    __device__ __forceinline__ void operator()(const f32x4 (&acc)[2][2][4][2], const Unit& u, int, int wr, int wc, int fr, int fq) const {
        const int row0 = u.row0 + wr * 64 + fr, col0 = u.col0 + wc * 32 + 8 * fq;
        EPI_LOOP_AM { const int row = row0 + ai * HALF + m * 16; const size_t off = (size_t)row * D + col0; const size_t goff = (size_t)row * GATEC + (SECOND ? D : 0) + col0;
#pragma unroll
            for (int bj = 0; bj < 2; ++bj) { const u32x4 gg = *(const u32x4*)(gates + goff + bj * HALF); const f32x4 g0 = bflo4(gg.x, gg.y), g1 = bflo4(gg.z, gg.w);
                f32x4 v0 = acc[ai][bj][m][0] * g0, v1 = acc[ai][bj][m][1] * g1;
                if (SECOND) { const u32x4 pp = *(const u32x4*)(pa + off + bj * HALF); v0 += bflo4(pp.x, pp.y); v1 += bflo4(pp.z, pp.w); }
                u32x4 w; w.x = cvt_pk_bf16(v0[0], v0[1]); w.y = cvt_pk_bf16(v0[2], v0[3]); w.z = cvt_pk_bf16(v1[0], v1[1]); w.w = cvt_pk_bf16(v1[2], v1[3]);
                *(u32x4*)((SECOND ? merged : pa) + off + bj * HALF) = w; } }
    }
};

struct BranchSched {
    StaticOrder so; const char *A1, *B1, *A2, *B2;
    __device__ __forceinline__ bool next(int i, Unit& u) const {
        int pm, pn; if (!so.next(i >> 1, pm, pn)) return false;
        const size_t step = (size_t)256 * 512 * 2; const bool first = (i & 1) == 0;
        u.a = (first ? A1 : A2) + (size_t)pm * step; u.b = (first ? B1 : B2) + (size_t)pn * step; u.aux = first ? 1 : 0;
        u.row0 = pm * BM; u.col0 = pn * BM; u.nrows = BM; u.rt = 0; return true;
    }
};
struct EpiBranch2 {
    static constexpr bool PERM = true;
    const bf16* gates; bf16* merged;
    __device__ __forceinline__ void operator()(f32x4 (&acc)[2][2][4][2], const Unit& u, int, int wr, int wc, int fr, int fq) const {
        const int row0 = u.row0 + wr * 64 + fr, col0 = u.col0 + wc * 32 + 8 * fq;
        if (u.aux == 1) {
            EPI_LOOP_AM { const int row = row0 + ai * HALF + m * 16; const size_t goff = (size_t)row * GATEC + col0;
#pragma unroll
                for (int bj = 0; bj < 2; ++bj) { const u32x4 ga = *(const u32x4*)(gates + goff + bj * HALF), gs = *(const u32x4*)(gates + goff + D + bj * HALF);
                    const f32x4 a0 = bflo4(ga.x, ga.y), a1 = bflo4(ga.z, ga.w), s0 = bflo4(gs.x, gs.y), s1 = bflo4(gs.z, gs.w);
#pragma unroll
                    for (int j = 0; j < 4; ++j) { acc[ai][bj][m][0][j] *= a0[j] * __builtin_amdgcn_rcpf(fmaxf(s0[j], 1e-30f)); acc[ai][bj][m][1][j] *= a1[j] * __builtin_amdgcn_rcpf(fmaxf(s1[j], 1e-30f)); } } }
        } else {
            EPI_LOOP_AM { const int row = row0 + ai * HALF + m * 16; const size_t off = (size_t)row * D + col0; const size_t goff = (size_t)row * GATEC + D + col0;
#pragma unroll
                for (int bj = 0; bj < 2; ++bj) { const u32x4 gg = *(const u32x4*)(gates + goff + bj * HALF); const f32x4 v0 = acc[ai][bj][m][0] * bflo4(gg.x, gg.y), v1 = acc[ai][bj][m][1] * bflo4(gg.z, gg.w);
                    u32x4 w; w.x = cvt_pk_bf16(v0[0], v0[1]); w.y = cvt_pk_bf16(v0[2], v0[3]); w.z = cvt_pk_bf16(v1[0], v1[1]); w.w = cvt_pk_bf16(v1[2], v1[3]);
                    *(u32x4*)(merged + off + bj * HALF) = w; } }
        }
    }
};
struct EpiDelta {
    static constexpr bool PERM = true;
    bf16* delta;
    __device__ __forceinline__ void operator()(const f32x4 (&acc)[2][2][4][2], const Unit& u, int, int wr, int wc, int fr, int fq) const {
        const int row0 = u.row0 + wr * 64 + fr, col0 = u.col0 + wc * 32 + 8 * fq;
        EPI_LOOP_AM { bf16* rowp = delta + (size_t)(row0 + ai * HALF + m * 16) * D + col0;
#pragma unroll
            for (int bj = 0; bj < 2; ++bj) { const f32x4 v0 = acc[ai][bj][m][0], v1 = acc[ai][bj][m][1];
                u32x4 w; w.x = cvt_pk_bf16(v0[0], v0[1]); w.y = cvt_pk_bf16(v0[2], v0[3]); w.z = cvt_pk_bf16(v1[0], v1[1]); w.w = cvt_pk_bf16(v1[2], v1[3]);
                *(u32x4*)(rowp + bj * HALF) = w; } }
    }
};
struct EpiOut {
    static constexpr bool PERM = false;
    const float* x; float* x1;
    __device__ __forceinline__ void operator()(const f32x4 (&acc)[2][2][4][2], const Unit& u, int, int wr, int wc, int fr, int fq) const {
        const int row0 = u.row0 + wr * 64 + fr, col0 = u.col0 + wc * 32 + 4 * fq;
        EPI_LOOP_AM { const size_t off = (size_t)(row0 + ai * HALF + m * 16) * D + col0;
#pragma unroll
            for (int bj = 0; bj < 2; ++bj)
#pragma unroll
                for (int n = 0; n < 2; ++n) { const f32x4 xv = *(const f32x4*)(x + off + bj * HALF + n * 16); *(f32x4*)(x1 + off + bj * HALF + n * 16) = xv + acc[ai][bj][m][n]; } }
    }
};

struct MoeSched {
    const LAS int* tpre; const LAS int* rbase;
    int U, G, c; const char* A; const char* B; size_t bstepE, bstepN, arow; bool gather;
    __device__ __forceinline__ bool next(int i, Unit& u) const {
        int L = i * G + c;
        if (G == 256) { const int xcd = c & 7, slot = c >> 3; L = 4 * (i * 64 + xcd * 8 + (slot >> 2)) + (slot & 3); }
        if (L >= U) return false;
        const int pn = L & 3; const int tile = tpre[L >> 2]; const int e = tile >> 8, rt = tile & 255;
        u.aux = e; u.rt = rt; u.row0 = rbase[e] + rt * BM; const int left = rbase[e + 1] - u.row0; u.nrows = left < BM ? left : BM; u.col0 = pn * BM;
        u.a = gather ? A : A + (size_t)u.row0 * arow; u.b = B + (size_t)e * bstepE + (size_t)pn * bstepN; return true;
    }
};
struct EpiAct {
    static constexpr bool PERM = true;
    bf16* act; const LAS int* rowtab;
    __device__ __forceinline__ void operator()(const f32x4 (&acc)[2][2][4][2], const Unit& u, int ui, int wr, int wc, int fr, int fq) const {
        const int acol = (u.col0 >> 1) + wc * 32 + 8 * fq;
        EPI_LOOP_AM { const int r = ai * HALF + wr * 64 + m * 16 + fr;
            if (r < u.nrows) { const float inv = __int_as_float(rowtab[2 * (ui * 256 + r) + 1]);
                float o[8];
#pragma unroll
                for (int n = 0; n < 2; ++n)
#pragma unroll
                    for (int j = 0; j < 4; ++j) { const float g = acc[ai][0][m][n][j] * inv, uu = acc[ai][1][m][n][j] * inv; o[4 * n + j] = g * sigm(g) * uu; }
                u32x4 w; w.x = cvt_pk_bf16(o[0], o[1]); w.y = cvt_pk_bf16(o[2], o[3]); w.z = cvt_pk_bf16(o[4], o[5]); w.w = cvt_pk_bf16(o[6], o[7]);
                *(u32x4*)(act + (size_t)(u.row0 + r) * DFF + acol) = w; } }
    }
};
struct EpiDown {
    static constexpr bool PERM = true;
    bf16* contrib; const LAS int* rowtab;
    __device__ __forceinline__ void operator()(const f32x4 (&acc)[2][2][4][2], const Unit& u, int ui, int wr, int wc, int fr, int fq) const {
        const int col0 = u.col0 + wc * 32 + 8 * fq;
        EPI_LOOP_AM { const int r = ai * HALF + wr * 64 + m * 16 + fr;
            if (r < u.nrows) { const int ent = rowtab[2 * (ui * 256 + r)]; const float wt = __int_as_float(rowtab[2 * (ui * 256 + r) + 1]);
                bf16* dst = contrib + ((size_t)(ent & 1) * M + (ent >> 1)) * D + col0;
#pragma unroll
                for (int bj = 0; bj < 2; ++bj) { const f32x4 v0 = acc[ai][bj][m][0] * wt, v1 = acc[ai][bj][m][1] * wt;
                    u32x4 w; w.x = cvt_pk_bf16(v0[0], v0[1]); w.y = cvt_pk_bf16(v0[2], v0[3]); w.z = cvt_pk_bf16(v1[0], v1[1]); w.w = cvt_pk_bf16(v1[2], v1[3]);
                    *(u32x4*)(dst + bj * HALF) = w; } } }
    }
};
}


__device__ __forceinline__ float gelu_fast(float x) {
    const float u = 0.7978845608028654f * (x + 0.044715f * x * x * x);
    const float e = __builtin_amdgcn_exp2f(2.885390081777927f * u);
    return 0.5f * x * (2.f - 2.f * __builtin_amdgcn_rcpf(e + 1.f));
}

namespace s5 {
typedef short bf16x8 __attribute__((ext_vector_type(8)));
typedef float f32x16 __attribute__((ext_vector_type(16)));
typedef unsigned u32x2 __attribute__((ext_vector_type(2)));
constexpr int ROWB = 272;
constexpr int WAVE_LDS = 32 * ROWB;
template <bool PHASE_C>
__device__ __forceinline__ void run(int un, const bf16* qkvu, const u32x4* bbt, const u32x4* cmt, const float2* lamb, const float2* lamL, float2* sse, const float* dsk, bf16* zbuf, LAS unsigned char* lds) {
    const int tid = threadIdx.x, lane = tid & 63, w = __builtin_amdgcn_readfirstlane(tid >> 6), j = lane & 31, h = lane >> 5;
    const int b = un >> 7, pair = (un & 127) >> 2, g = (un & 3) * 8 + w;
    const int ksub = 2 * pair + h;
    const float2 lam0 = lamb[g * PS + j], lam1 = lamb[g * PS + 32 + j];
    bf16x8 bfrag[4];
#pragma unroll
    for (int t = 0; t < 4; ++t) bfrag[t] = __builtin_bit_cast(bf16x8, bbt[(g * 4 + t) * 64 + lane]);
    const int r = lane & 31, sA = (r >> 2) & 1, tokA = 4 * (r >> 3) + (r & 3);
    const bf16* up = qkvu + ((size_t)b * SEQ + (size_t)(2 * pair + sA) * LSUB + tokA) * QKVU_LD + UOFF + g * GC + 8 * h;
    u32x4 afr[8];
#pragma unroll
    for (int st = 0; st < 8; ++st) afr[st] = *(const u32x4*)(up + (size_t)st * 16 * QKVU_LD);
    float s0r = 0.f, s0i = 0.f, s1r = 0.f, s1i = 0.f;
    if (PHASE_C) {
        const float2 L0 = lamL[g * PS + j], L1 = lamL[g * PS + 32 + j];
        const float2* e0 = sse + ((size_t)b * NSUB * NG + g) * PS + j;
        const int kmax = 2 * pair + 1;
#pragma unroll 1
        for (int m0 = 0; m0 < kmax; m0 += 16) {
            float2 ea[16], eb[16];
#pragma unroll
            for (int q = 0; q < 16; ++q) { const int m = m0 + q; const int mm = (m < ksub) ? m : 0;
                ea[q] = e0[(size_t)mm * NG * PS]; eb[q] = e0[(size_t)mm * NG * PS + 32]; }
#pragma unroll
            for (int q = 0; q < 16; ++q) { const bool ok = (m0 + q) < ksub;
                const float n0r = opq(opq(L0.x * s0r + ea[q].x) - L0.y * s0i), n0i = opq(opq(L0.x * s0i + ea[q].y) + L0.y * s0r);
                const float n1r = opq(opq(L1.x * s1r + eb[q].x) - L1.y * s1i), n1i = opq(opq(L1.x * s1i + eb[q].y) + L1.y * s1r);
                s0r = ok ? n0r : s0r; s0i = ok ? n0i : s0i; s1r = ok ? n1r : s1r; s1i = ok ? n1i : s1i; }
        }
    }
    bf16x8 cfr[4]; f32x4 dsk4 = {0.f, 0.f, 0.f, 0.f};
    if (PHASE_C) {
#pragma unroll
        for (int ks = 0; ks < 4; ++ks) cfr[ks] = __builtin_bit_cast(bf16x8, cmt[(g * 4 + ks) * 64 + lane]);
        dsk4 = *(const f32x4*)(dsk + g * GC + 4 * (lane >> 4));
    }
    LAS unsigned char* wl = lds + w * WAVE_LDS;
    const f32x16 zero16 = {0.f, 0.f, 0.f, 0.f, 0.f, 0.f, 0.f, 0.f, 0.f, 0.f, 0.f, 0.f, 0.f, 0.f, 0.f, 0.f};
#pragma unroll 1
    for (int st = 0; st < 8; ++st) {
        u32x4 av = afr[0];
#pragma unroll
        for (int q = 1; q < 8; ++q) av = (st == q) ? afr[q] : av;
        const bf16x8 a = __builtin_bit_cast(bf16x8, av);
        f32x16 t0 = __builtin_amdgcn_mfma_f32_32x32x16_bf16(a, bfrag[0], zero16, 0, 0, 0);
        mfma_keep(a, bfrag[0], t0[0]);
        f32x16 t1 = __builtin_amdgcn_mfma_f32_32x32x16_bf16(a, bfrag[1], zero16, 0, 0, 0);
        mfma_keep(a, bfrag[1], t1[0]);
        f32x16 t2 = __builtin_amdgcn_mfma_f32_32x32x16_bf16(a, bfrag[2], zero16, 0, 0, 0);
        mfma_keep(a, bfrag[2], t2[0]);
        f32x16 t3 = __builtin_amdgcn_mfma_f32_32x32x16_bf16(a, bfrag[3], zero16, 0, 0, 0);
        mfma_keep(a, bfrag[3], t3[0]);
#pragma unroll
        for (int i = 0; i < 16; ++i) {
            const float n0r = opq(opq(lam0.x * s0r + t0[i]) - lam0.y * s0i), n0i = opq(opq(lam0.x * s0i + t1[i]) + lam0.y * s0r); s0r = n0r; s0i = n0i;
            const float n1r = opq(opq(lam1.x * s1r + t2[i]) - lam1.y * s1i), n1i = opq(opq(lam1.x * s1i + t3[i]) + lam1.y * s1r); s1r = n1r; s1i = n1i;
            if (PHASE_C) { u32x2 pk; pk.x = pg8::cvt_pk_bf16(s0r, s0i); pk.y = pg8::cvt_pk_bf16(s1r, s1i);
                *(LAS u32x2*)(wl + (h * 16 + i) * ROWB + 8 * j) = pk; }
        }
        if (PHASE_C) {
            asm volatile("" ::: "memory");
#pragma unroll
            for (int nt = 0; nt < 2; ++nt) {
                f32x4 y = {0.f, 0.f, 0.f, 0.f};
#pragma unroll
                for (int ks = 0; ks < 4; ++ks) { const bf16x8 sb = __builtin_bit_cast(bf16x8, *(const LAS u32x4*)(wl + (nt * 16 + (lane & 15)) * ROWB + (ks * 32 + 8 * (lane >> 4)) * 2));
                    y = __builtin_amdgcn_mfma_f32_16x16x32_bf16(cfr[ks], sb, y, 0, 0, 0); mfma_keep(cfr[ks], sb, y[0]); }
                const size_t row = (size_t)b * SEQ + (size_t)(2 * pair + nt) * LSUB + st * 16 + (lane & 15);
                const u32x2 uu = *(const u32x2*)(qkvu + row * QKVU_LD + UOFF + g * GC + 4 * (lane >> 4));
                const f32x4 uf = pg8::bflo4(uu.x, uu.y);
                const f32x4 v = y + dsk4 * uf;
                u32x2 o; o.x = pg8::cvt_pk_bf16(gelu_fast(v[0]), gelu_fast(v[1])); o.y = pg8::cvt_pk_bf16(gelu_fast(v[2]), gelu_fast(v[3]));
                *(u32x2*)(zbuf + row * DSSM + g * GC + 4 * (lane >> 4)) = o;
            }
            asm volatile("" ::: "memory");
        }
    }
    if (!PHASE_C) { float2* e = sse + (((size_t)b * NSUB + ksub) * NG + g) * PS; e[j] = make_float2(s0r, s0i); e[32 + j] = make_float2(s1r, s1i); }
}
}

__device__ __forceinline__ unsigned pk2(float lo, float hi) { return (unsigned)f2bf(lo) | ((unsigned)f2bf(hi) << 16); }
struct CvDesc { const float* W; bf16* dst; const float* ksc; int N, K; };
__device__ __forceinline__ void cv_load(const CvDesc& d, int lane, f32x4 (&tv)[8]) {
    const float* p = d.W + (size_t)(lane >> 3) * d.N + 4 * (lane & 7);
#pragma unroll
    for (int i = 0; i < 8; ++i) tv[i] = __builtin_nontemporal_load((const f32x4*)(p + (size_t)(8 * i) * d.N));
}
__device__ __forceinline__ void cv_finish(const CvDesc& d, int lane, const f32x4 (&tv)[8], LAS float* scr) {
#pragma unroll
    for (int i = 0; i < 8; ++i) { LAS float* w = scr + ((lane >> 3) + 8 * i) * 33 + 4 * (lane & 7); w[0] = tv[i][0]; w[1] = tv[i][1]; w[2] = tv[i][2]; w[3] = tv[i][3]; }
    asm volatile("s_waitcnt lgkmcnt(0)" ::: "memory");
    const int c = lane & 7;
    f32x4 g0 = {1.f, 1.f, 1.f, 1.f}, g1 = g0;
    if (d.ksc) { g0 = *(const f32x4*)(d.ksc + 8 * c); g1 = *(const f32x4*)(d.ksc + 8 * c + 4); }
#pragma unroll
    for (int jj = 0; jj < 4; ++jj) { const int n = (lane >> 3) + 8 * jj; const LAS float* sp = scr + (8 * c) * 33 + n;
        u32x4 o; o.x = pk2(sp[0 * 33] * g0[0], sp[1 * 33] * g0[1]); o.y = pk2(sp[2 * 33] * g0[2], sp[3 * 33] * g0[3]); o.z = pk2(sp[4 * 33] * g1[0], sp[5 * 33] * g1[1]); o.w = pk2(sp[6 * 33] * g1[2], sp[7 * 33] * g1[3]);
        *(u32x4*)(d.dst + (size_t)n * d.K + 8 * c) = o; }
    asm volatile("s_waitcnt lgkmcnt(0)" ::: "memory");
}

namespace att {
typedef short bf16x8 __attribute__((ext_vector_type(8)));
typedef float f32x16 __attribute__((ext_vector_type(16)));
typedef unsigned u32x2 __attribute__((ext_vector_type(2)));
constexpr int KP = 144, VP = 520, V_OFF = 256 * KP;
__device__ __forceinline__ void load_kv(int un, const bf16* qkvu, u32x4 (&kvreg)[8]) {
    const int tid = threadIdx.x, b = un >> 7, nb = (un >> 1) & 63, kvh = un & 1, blk = nb * 128; const size_t rowbase = (size_t)b * SEQ;
#pragma unroll
    for (int cc = 0; cc < 4; ++cc) { const int c = tid + 512 * cc, key = c >> 3, dc = c & 7; int kp = blk - 128 + key; kp = kp < 0 ? 0 : kp;
        const bf16* src = qkvu + (rowbase + kp) * QKVU_LD + kvh * HD + dc * 8;
        kvreg[2 * cc] = *(const u32x4*)(src + KOFF); kvreg[2 * cc + 1] = *(const u32x4*)(src + VOFF); }
}
__device__ __forceinline__ void unit(int un, const bf16* qkvu, const float* sinks, bf16* attn, LAS unsigned char* lds, const u32x4 (&kvreg)[8]) {
    const int tid = threadIdx.x, lane = tid & 63, w = __builtin_amdgcn_readfirstlane(tid >> 6), l31 = lane & 31, h = lane >> 5;
    const int b = un >> 7, nb = (un >> 1) & 63, kvh = un & 1, blk = nb * 128; const size_t rowbase = (size_t)b * SEQ;
    __syncthreads();
#pragma unroll
    for (int cc = 0; cc < 4; ++cc) { const int c = tid + 512 * cc, key = c >> 3, dc = c & 7;
        const u32x4 kv = kvreg[2 * cc], vv = kvreg[2 * cc + 1];
        *(LAS u32x4*)(lds + key * KP + dc * 16) = kv;
#pragma unroll
        for (int i = 0; i < 4; ++i) { *(LAS bf16*)(lds + V_OFF + (dc * 8 + 2 * i) * VP + key * 2) = (bf16)(vv[i] & 0xffffu); *(LAS bf16*)(lds + V_OFF + (dc * 8 + 2 * i + 1) * VP + key * 2) = (bf16)(vv[i] >> 16); } }
    __syncthreads();
    const int hq = kvh * 4 + (w >> 1), qh = w & 1;
    const float sink2 = sinks[hq] * 1.4426950408889634f;
    const float c1 = 0.125f * 1.4426950408889634f;
    const f32x16 zero16 = {0.f, 0.f, 0.f, 0.f, 0.f, 0.f, 0.f, 0.f, 0.f, 0.f, 0.f, 0.f, 0.f, 0.f, 0.f, 0.f};
#pragma unroll 1
    for (int qt = 0; qt < 2; ++qt) {
        const int q0 = qh * 64 + qt * 32, kt0 = q0 >> 5, iq = q0 + l31;
        const size_t qrow = rowbase + blk + iq;
        bf16x8 qf[4];
#pragma unroll
        for (int s = 0; s < 4; ++s) qf[s] = __builtin_bit_cast(bf16x8, *(const u32x4*)(qkvu + qrow * QKVU_LD + QOFF + hq * HD + 16 * s + 8 * h));
        f32x16 sc[5];
#pragma unroll
        for (int t = 0; t < 5; ++t) { f32x16 acc = zero16;
#pragma unroll
            for (int s = 0; s < 4; ++s) { const bf16x8 kf = *(const LAS bf16x8*)(lds + ((kt0 + t) * 32 + l31) * KP + (16 * s + 8 * h) * 2); acc = __builtin_amdgcn_mfma_f32_32x32x16_bf16(kf, qf[s], acc, 0, 0, 0); mfma_keep(kf, qf[s], acc[0]); }
            sc[t] = acc; }
        float mx = sink2;
#pragma unroll
        for (int t = 0; t < 5; ++t)
#pragma unroll
            for (int i = 0; i < 16; ++i) { const int jk = (kt0 + t) * 32 + (i & 3) + 8 * (i >> 2) + 4 * h; const int rel = jk - iq; const bool ok = (rel >= 1) && (rel <= 128) && (blk - 128 + jk >= 0);
                const float v = ok ? sc[t][i] * c1 : -INFINITY; sc[t][i] = v; mx = fmaxf(mx, v); }
        mx = fmaxf(mx, __shfl_xor(mx, 32));
        float sum = 0.f;
#pragma unroll
        for (int t = 0; t < 5; ++t)
#pragma unroll
            for (int i = 0; i < 16; ++i) { const float p = __builtin_amdgcn_exp2f(sc[t][i] - mx); sc[t][i] = p; sum += p; }
        sum += __shfl_xor(sum, 32);
        const float rinv = 1.f / (sum + __builtin_amdgcn_exp2f(sink2 - mx));
        f32x16 o0 = zero16, o1 = zero16;
#pragma unroll
        for (int t = 0; t < 5; ++t)
#pragma unroll
            for (int s = 0; s < 2; ++s) {
                u32x4 pw; pw.x = pg8::cvt_pk_bf16(sc[t][8 * s + 0], sc[t][8 * s + 1]); pw.y = pg8::cvt_pk_bf16(sc[t][8 * s + 2], sc[t][8 * s + 3]); pw.z = pg8::cvt_pk_bf16(sc[t][8 * s + 4], sc[t][8 * s + 5]); pw.w = pg8::cvt_pk_bf16(sc[t][8 * s + 6], sc[t][8 * s + 7]);
                const bf16x8 pb = __builtin_bit_cast(bf16x8, pw);
                const int kofs = ((kt0 + t) * 32 + 16 * s + 4 * h) * 2;
                { const u32x2 a = *(const LAS u32x2*)(lds + V_OFF + l31 * VP + kofs), c = *(const LAS u32x2*)(lds + V_OFF + l31 * VP + kofs + 16); u32x4 vw; vw.x = a.x; vw.y = a.y; vw.z = c.x; vw.w = c.y;
                  const bf16x8 va = __builtin_bit_cast(bf16x8, vw); o0 = __builtin_amdgcn_mfma_f32_32x32x16_bf16(va, pb, o0, 0, 0, 0); mfma_keep(va, pb, o0[0]); }
                { const u32x2 a = *(const LAS u32x2*)(lds + V_OFF + (32 + l31) * VP + kofs), c = *(const LAS u32x2*)(lds + V_OFF + (32 + l31) * VP + kofs + 16); u32x4 vw; vw.x = a.x; vw.y = a.y; vw.z = c.x; vw.w = c.y;
                  const bf16x8 va = __builtin_bit_cast(bf16x8, vw); o1 = __builtin_amdgcn_mfma_f32_32x32x16_bf16(va, pb, o1, 0, 0, 0); mfma_keep(va, pb, o1[0]); }
            }
        bf16* orow = attn + qrow * DATT + hq * HD + 4 * h;
#pragma unroll
        for (int a = 0; a < 4; ++a) { u32x2 w0, w1; w0.x = pg8::cvt_pk_bf16(o0[4 * a] * rinv, o0[4 * a + 1] * rinv); w0.y = pg8::cvt_pk_bf16(o0[4 * a + 2] * rinv, o0[4 * a + 3] * rinv);
            w1.x = pg8::cvt_pk_bf16(o1[4 * a] * rinv, o1[4 * a + 1] * rinv); w1.y = pg8::cvt_pk_bf16(o1[4 * a + 2] * rinv, o1[4 * a + 3] * rinv);
            *(u32x2*)(orow + 8 * a) = w0; *(u32x2*)(orow + 32 + 8 * a) = w1; }
    }
}
}

#define XB_TMO      128
#define XB_XCNT(j)  (256  + 64 * (j))
#define XB_XSUB(j)  (1280 + 64 * (j))
#define XB_XGEN(j)  (2304 + 64 * (j))
#define XB_TOP      3328
#define XB_TOPGEN   3392
#define XCD_BAR_WORDS 3456
#ifndef XB_SPIN_CAP
#define XB_SPIN_CAP (1u << 24)
#endif
__device__ __forceinline__ unsigned xb_ld(unsigned* p)              { return __hip_atomic_load(p, __ATOMIC_RELAXED, __HIP_MEMORY_SCOPE_AGENT); }
__device__ __forceinline__ unsigned xb_add(unsigned* p, unsigned v) { return __hip_atomic_fetch_add(p, v, __ATOMIC_RELAXED, __HIP_MEMORY_SCOPE_AGENT); }
__device__ __forceinline__ unsigned xb_xcc_id() { return (unsigned)__builtin_amdgcn_s_getreg((3 << 11) | 20) & 0xFu; }
#define XB_SPIN(cond, bar) do { unsigned _sp = 0; while (cond) { __builtin_amdgcn_s_sleep(1); \
    if ((++_sp & 255u) == 0u) { if (xb_ld(&(bar)[XB_TMO])) break; if (_sp > XB_SPIN_CAP) { atomicAdd(&(bar)[XB_TMO], 1u); break; } } } } while (0)
struct XcdBarrier { unsigned* bar; unsigned x; volatile LAS unsigned* st; };
__device__ __forceinline__ XcdBarrier xcd_barrier_post(unsigned* bar, volatile LAS unsigned* st) {
    XcdBarrier b; b.bar = bar; b.x = xb_xcc_id(); b.st = st;
    if (threadIdx.x == 0) (void)xb_add(&bar[XB_XCNT(b.x)], 1u);
    return b;
}
__device__ __forceinline__ void xcd_barrier_complete(unsigned* bar, unsigned x, unsigned& nloc, unsigned& nx) {
    const unsigned G = gridDim.x * gridDim.y * gridDim.z;
    unsigned sum, cnt, mine, sp = 0u;
    for (;;) {
        sum = 0u; cnt = 0u; mine = 0u;
#pragma unroll
        for (unsigned j = 0; j < 16; ++j) { const unsigned c = xb_ld(&bar[XB_XCNT(j)]); sum += c; cnt += (c > 0u) ? 1u : 0u; mine = (j == x) ? c : mine; }
        if (sum == G) break;
        __builtin_amdgcn_s_sleep(1);
        if ((++sp & 255u) == 0u) { if (xb_ld(&bar[XB_TMO])) break; if (sp > XB_SPIN_CAP) { atomicAdd(&bar[XB_TMO], 1u); break; } }
    }
    nloc = mine > 0u ? mine : 1u; nx = cnt > 0u ? cnt : 1u;
}
__device__ __forceinline__ void xcd_barrier(const XcdBarrier& b) {
    asm volatile("s_waitcnt vmcnt(0)" ::: "memory");
    __syncthreads();
    if (threadIdx.x == 0) {
        unsigned* bar = b.bar;
        __builtin_amdgcn_s_waitcnt(0);
        unsigned nloc = b.st[0], nx = b.st[1];
        if (nloc == 0u) { xcd_barrier_complete(bar, b.x, nloc, nx); b.st[0] = nloc; b.st[1] = nx; }
        const unsigned old = xb_add(&bar[XB_XSUB(b.x)], 1u);
        const unsigned gen = old / nloc;
        if (old + 1u == (gen + 1u) * nloc) {
            __builtin_amdgcn_fence(__ATOMIC_RELEASE, "agent");
            asm volatile("s_waitcnt vmcnt(0)" ::: "memory");
            const unsigned og = xb_add(&bar[XB_TOP], 1u);
            const unsigned tg = og / nx;
            if (og + 1u == (tg + 1u) * nx) xb_add(&bar[XB_TOPGEN], 1u);
            else XB_SPIN(xb_ld(&bar[XB_TOPGEN]) == tg, bar);
            __builtin_amdgcn_fence(__ATOMIC_ACQUIRE, "agent");
            xb_add(&bar[XB_XGEN(b.x)], 1u);
            asm volatile("s_waitcnt vmcnt(0)" ::: "memory");
        } else {
            XB_SPIN(xb_ld(&bar[XB_XGEN(b.x)]) == gen, bar);
            __builtin_amdgcn_fence(__ATOMIC_ACQUIRE, "agent");
            asm volatile("s_waitcnt vmcnt(0)" ::: "memory");
        }
    }
    __syncthreads();
}

struct XbTicket { unsigned mode, val; };
__device__ __forceinline__ XbTicket xcd_barrier_arrive(const XcdBarrier& b) {
    XbTicket t; t.mode = 0u; t.val = 0u;
    asm volatile("s_waitcnt vmcnt(0)" ::: "memory");
    __syncthreads();
    if (threadIdx.x == 0) {
        unsigned* bar = b.bar;
        __builtin_amdgcn_s_waitcnt(0);
        unsigned nloc = b.st[0], nx = b.st[1];
        if (nloc == 0u) { xcd_barrier_complete(bar, b.x, nloc, nx); b.st[0] = nloc; b.st[1] = nx; }
        const unsigned old = xb_add(&bar[XB_XSUB(b.x)], 1u);
        const unsigned gen = old / nloc;
        if (old + 1u == (gen + 1u) * nloc) {
            __builtin_amdgcn_fence(__ATOMIC_RELEASE, "agent");
            asm volatile("s_waitcnt vmcnt(0)" ::: "memory");
            const unsigned og = xb_add(&bar[XB_TOP], 1u);
            const unsigned tg = og / nx;
            if (og + 1u == (tg + 1u) * nx) { xb_add(&bar[XB_TOPGEN], 1u); t.mode = 0u; }
            else { t.mode = 1u; t.val = tg; }
        } else { t.mode = 2u; t.val = gen; }
    }
    return t;
}
__device__ __forceinline__ void xcd_barrier_wait(const XcdBarrier& b, const XbTicket& t) {
    asm volatile("s_waitcnt vmcnt(0)" ::: "memory");
    __syncthreads();
    if (threadIdx.x == 0) {
        unsigned* bar = b.bar;
        if (t.mode <= 1u) {
            if (t.mode == 1u) XB_SPIN(xb_ld(&bar[XB_TOPGEN]) == t.val, bar);
            __builtin_amdgcn_fence(__ATOMIC_ACQUIRE, "agent");
            xb_add(&bar[XB_XGEN(b.x)], 1u);
            asm volatile("s_waitcnt vmcnt(0)" ::: "memory");
        } else {
            XB_SPIN(xb_ld(&bar[XB_XGEN(b.x)]) == t.val, bar);
            __builtin_amdgcn_fence(__ATOMIC_ACQUIRE, "agent");
            asm volatile("s_waitcnt vmcnt(0)" ::: "memory");
        }
    }
    __syncthreads();
}

struct Args { const float* in[27]; float* out; unsigned char* ws; int ph_lo, ph_hi; };

template <class F>
__device__ __forceinline__ void naive_gemm(const bf16* A, int lda, const bf16* Bt, int ldb, int Mr, int N, int K, F epi, long gt, long NT) {
    for (long idx = gt; idx < (long)Mr * N; idx += NT) {
        const int m = (int)(idx / N), n = (int)(idx % N);
        const u32x4* a = (const u32x4*)(A + (size_t)m * lda); const u32x4* b = (const u32x4*)(Bt + (size_t)n * ldb);
        float acc = 0.f;
#pragma unroll 4
        for (int k8 = 0; k8 < K / 8; ++k8) acc += dot8(a[k8], b[k8]);
        epi(m, n, acc);
    }
}

__global__ void __launch_bounds__(NTHREADS, 2) fwd(Args args) {
    extern __shared__ __attribute__((aligned(16))) unsigned char lds[];
#define PH_IDX const int tid = threadIdx.x, lane = tid & 63, wave = tid >> 6; const long gt = (long)blockIdx.x * NTHREADS + tid, NT = (long)gridDim.x * NTHREADS; \
    const int gw = blockIdx.x * NWAVES + wave, NW = gridDim.x * NWAVES; (void)lane; (void)gt; (void)NT; (void)gw; (void)NW;
    unsigned char* ws = args.ws;
    unsigned* ctl = (unsigned*)(ws + WS_CTL);
    const float* x = args.in[0];
    float* out = args.out;
    unsigned char* dout_b = (unsigned char*)args.out;
    bf16* WinT = (bf16*)(ws + WS_WIN); bf16* WgluT = (bf16*)(ws + WS_WGLU); bf16* WaT = (bf16*)(ws + WS_WA); bf16* WsT = (bf16*)(ws + WS_WS); bf16* WoutT = (bf16*)(ws + WS_WOUT);
    bf16* WguT = (bf16*)(ws + WS_WGU); bf16* WdT = (bf16*)(ws + WS_WD);
    bf16* hbuf = (bf16*)(ws + WS_R1); bf16* act = (bf16*)(ws + WS_R1); bf16* pabuf = (bf16*)(ws + WS_R1);
    LAS unsigned char* ldsp = (LAS unsigned char*)lds;
    bf16* gates = (bf16*)(ws + WS_GATES); bf16* delta = (bf16*)(ws + WS_GATES);
    bf16* contrib = (bf16*)(ws + WS_WGU);
    bf16* qkvu = (bf16*)(ws + WS_QKVU); bf16* merged = (bf16*)(ws + WS_QKVU); bf16* h2u = (bf16*)(ws + WS_QKVU);
    bf16* attn = (bf16*)(dout_b + DO_ATTN); bf16* zbuf = (bf16*)(dout_b + DO_Z); bf16* zg = (bf16*)(dout_b + DO_ZG);
    float2* lamb = (float2*)(ws + WS_PAR + PAR_LAMB); float2* lamL = (float2*)(ws + WS_PAR + PAR_LAML); float2* bbar = (float2*)(ws + WS_PAR + PAR_BBAR);
    u32x4* bbt = (u32x4*)(ws + WS_PAR + PAR_BBT); u32x4* cmt = (u32x4*)(ws + WS_PAR + PAR_CMT); float2* sse = (float2*)(ws + WS_SSE);
    bf16* rwh = (bf16*)(ws + WS_PAR + PAR_RWH); bf16* rwl = (bf16*)(ws + WS_PAR + PAR_RWL);
    int* lists = (int*)(ws + WS_LIST);
    int* tok_e = (int*)(ws + WS_TOK + TOK_E); int* tok_slot = (int*)(ws + WS_TOK + TOK_SLOT); float* tok_w = (float*)(ws + WS_TOK + TOK_W); float* tok_inv = (float*)(ws + WS_TOK + TOK_INV);
    unsigned* ecnt = ctl + CW_CNT;
    const int lo = args.ph_lo, hi = args.ph_hi;
#define IN(k) (lo <= (k) && (k) < hi)
#define BOTH(k, k2) (IN(k) && IN(k2))
    if (threadIdx.x < 4) ((LAS unsigned*)(ldsp + LDS_BARW))[threadIdx.x] = 0u;
    __syncthreads();
    XcdBarrier gbar; gbar.bar = ctl + CW_BAR; gbar.x = 0; gbar.st = nullptr;
    if (hi - lo > 1) gbar = xcd_barrier_post(ctl + CW_BAR, (volatile LAS unsigned*)(ldsp + LDS_BARW));
#define GRID_BAR(k, k2) do { if (BOTH(k, k2)) xcd_barrier(gbar); } while (0)

    constexpr int CV_IN = (D / 64) * (INC / 32), CV_GLU = (DSSM / 64) * (DSSM / 32), CV_A = (DATT / 64) * (D / 32), CV_S = (DSSM / 64) * (D / 32), CV_O = (D / 64) * (D / 32);
    constexpr int CV_EG = (D / 64) * (DFF / 32), CV_ED = (DFF / 64) * (D / 32);
    constexpr int CV_ALL = CV_IN + CV_GLU + CV_A + CV_S + CV_O + NE * (2 * CV_EG + CV_ED);
    auto cv_decode = [&](int r) __attribute__((always_inline)) -> CvDesc {
        CvDesc d; d.ksc = nullptr;
        if (r < CV_IN) { const int nb = INC / 32, k0 = 64 * (r / nb), n0 = 32 * (r % nb); d.W = args.in[2] + (size_t)k0 * INC + n0; d.N = INC; d.K = D; d.dst = WinT + (size_t)n0 * D + k0; return d; } r -= CV_IN;
        if (r < CV_GLU) { const int nb = DSSM / 32, k0 = 64 * (r / nb), n0 = 32 * (r % nb); d.W = args.in[13] + (size_t)k0 * DSSM + n0; d.N = DSSM; d.K = DSSM; d.dst = WgluT + (size_t)n0 * DSSM + k0; return d; } r -= CV_GLU;
        if (r < CV_A) { const int nb = D / 32, k0 = 64 * (r / nb), n0 = 32 * (r % nb); d.W = args.in[15] + (size_t)k0 * D + n0; d.N = D; d.K = DATT; d.dst = WaT + (size_t)n0 * DATT + k0; return d; } r -= CV_A;
        if (r < CV_S) { const int nb = D / 32, k0 = 64 * (r / nb), n0 = 32 * (r % nb); d.W = args.in[16] + (size_t)k0 * D + n0; d.N = D; d.K = DSSM; d.dst = WsT + (size_t)n0 * DSSM + k0; return d; } r -= CV_S;
        if (r < CV_O) { const int nb = D / 32, k0 = 64 * (r / nb), n0 = 32 * (r % nb); d.W = args.in[17] + (size_t)k0 * D + n0; d.N = D; d.K = D; d.dst = WoutT + (size_t)n0 * D + k0; return d; } r -= CV_O;
        if (r < NE * 2 * CV_EG) { const int e = r / (2 * CV_EG); r -= e * (2 * CV_EG); const int up = r >= CV_EG; if (up) r -= CV_EG; const int nb = DFF / 32, k0 = 64 * (r / nb), n0 = 32 * (r % nb);
            const int np0 = 256 * (n0 >> 7) + (n0 & 127) + (up ? 128 : 0);
            d.W = (up ? args.in[24] : args.in[23]) + ((size_t)e * D + k0) * DFF + n0; d.N = DFF; d.K = D; d.dst = WguT + ((size_t)e * 1024 + np0) * D + k0; d.ksc = args.in[18] + k0; return d; }
        r -= NE * 2 * CV_EG;
        { const int e = r / CV_ED; r -= e * CV_ED; const int nb = D / 32, k0 = 64 * (r / nb), n0 = 32 * (r % nb); d.W = args.in[25] + ((size_t)e * DFF + k0) * D + n0; d.N = D; d.K = DFF; d.dst = WdT + ((size_t)e * D + n0) * DFF + k0; }
        return d;
    };
    auto cv_run = [&](int first, int stride, int count, LAS float* scr, int lane) __attribute__((always_inline)) {
        if (count <= 0) return;
        f32x4 t0[8], t1[8], t2[8], t3[8];
        CvDesc d0 = cv_decode(first), d1 = d0, d2 = d0, d3 = d0;
        cv_load(d0, lane, t0);
        if (count > 1) { d1 = cv_decode(first + stride); cv_load(d1, lane, t1); }
        if (count > 2) { d2 = cv_decode(first + 2 * stride); cv_load(d2, lane, t2); }
#pragma unroll 1
        for (int j = 0; j < count; j += 4) {
            if (j + 3 < count) { d3 = cv_decode(first + (j + 3) * stride); cv_load(d3, lane, t3); }
            cv_finish(d0, lane, t0, scr);
            if (j + 4 < count) { d0 = cv_decode(first + (j + 4) * stride); cv_load(d0, lane, t0); }
            if (j + 1 < count) cv_finish(d1, lane, t1, scr);
            if (j + 5 < count) { d1 = cv_decode(first + (j + 5) * stride); cv_load(d1, lane, t1); }
            if (j + 2 < count) cv_finish(d2, lane, t2, scr);
            if (j + 6 < count) { d2 = cv_decode(first + (j + 6) * stride); cv_load(d2, lane, t2); }
            if (j + 3 < count) cv_finish(d3, lane, t3, scr);
        }
    };

    if (IN(0)) {
        PH_IDX
#if FAST_P0
        {
            LAS float* scr = (LAS float*)(ldsp + wave * 8448);
            cv_run(gw, NW, (CV_IN + CV_P0X - gw + NW - 1) / NW, scr, lane);
        }
        { const float* g = args.in[1]; f32x4 gv[4];
#pragma unroll
          for (int j = 0; j < 4; ++j) gv[j] = *(const f32x4*)(g + 256 * j + 4 * lane);
          f32x4 vn[4];
          if (gw < M) {
#pragma unroll
              for (int j = 0; j < 4; ++j) vn[j] = __builtin_nontemporal_load((const f32x4*)(x + (size_t)gw * D + 256 * j + 4 * lane)); }
#pragma unroll 1
          for (int m = gw; m < M; m += NW) { f32x4 v[4]; float ss = 0.f;
#pragma unroll
              for (int j = 0; j < 4; ++j) v[j] = vn[j];
              if (m + NW < M) {
#pragma unroll
                  for (int j = 0; j < 4; ++j) vn[j] = __builtin_nontemporal_load((const f32x4*)(x + (size_t)(m + NW) * D + 256 * j + 4 * lane)); }
#pragma unroll
              for (int j = 0; j < 4; ++j) ss += v[j][0] * v[j][0] + v[j][1] * v[j][1] + v[j][2] * v[j][2] + v[j][3] * v[j][3];
              const float inv = 1.f / sqrtf(wave_sum(ss) * (1.f / D) + EPS);
#pragma unroll
              for (int j = 0; j < 4; ++j) { const f32x4 t = v[j] * inv * gv[j]; unsigned long long o = (unsigned long long)pk2(t[0], t[1]) | ((unsigned long long)pk2(t[2], t[3]) << 32);
                  *(unsigned long long*)(hbuf + (size_t)m * D + 256 * j + 4 * lane) = o; } } }
#else
        { const float* W = args.in[2]; for (long i = gt; i < (long)INC * D; i += NT) { const int n = (int)(i / D), k = (int)(i % D); WinT[i] = f2bf(W[(size_t)k * INC + n]); } }
        { const float* W = args.in[13]; for (long i = gt; i < (long)DSSM * DSSM; i += NT) { const int n = (int)(i / DSSM), k = (int)(i % DSSM); WgluT[i] = f2bf(W[(size_t)k * DSSM + n]); } }
        { const float* W = args.in[15]; for (long i = gt; i < (long)D * DATT; i += NT) { const int n = (int)(i / DATT), k = (int)(i % DATT); WaT[i] = f2bf(W[(size_t)k * D + n]); } }
        { const float* W = args.in[16]; for (long i = gt; i < (long)D * DSSM; i += NT) { const int n = (int)(i / DSSM), k = (int)(i % DSSM); WsT[i] = f2bf(W[(size_t)k * D + n]); } }
        { const float* W = args.in[17]; for (long i = gt; i < (long)D * D; i += NT) { const int n = (int)(i / D), k = (int)(i % D); WoutT[i] = f2bf(W[(size_t)k * D + n]); } }
        { const float* Wg = args.in[23]; const float* Wu = args.in[24];
          for (long i = gt; i < (long)NE * 1024 * D; i += NT) { const int k = (int)(i % D); const int np = (int)((i / D) % 1024); const int e = (int)(i / ((long)D * 1024));
              const int pn = np >> 8, bj = (np >> 7) & 1, jj = np & 127; const float* W = bj ? Wu : Wg;
              WguT[i] = f2bf(W[((size_t)e * D + k) * DFF + 128 * pn + jj]); } }
        { const float* W = args.in[25];
          for (long i = gt; i < (long)NE * D * DFF; i += NT) { const int k = (int)(i % DFF); const int n = (int)((i / DFF) % D); const int e = (int)(i / ((long)DFF * D));
              WdT[i] = f2bf(W[((size_t)e * DFF + k) * D + n]); } }
        { const float* g = args.in[1];
          for (int m = gw; m < M; m += NW) { const float* xr = x + (size_t)m * D; float v[16]; float ss = 0.f;
#pragma unroll
              for (int j = 0; j < 4; ++j) { const f32x4 t = *(const f32x4*)(xr + 256 * j + 4 * lane); v[4 * j] = t[0]; v[4 * j + 1] = t[1]; v[4 * j + 2] = t[2]; v[4 * j + 3] = t[3]; ss += t[0] * t[0] + t[1] * t[1] + t[2] * t[2] + t[3] * t[3]; }
              const float inv = 1.f / sqrtf(wave_sum(ss) * (1.f / D) + EPS);
#pragma unroll
              for (int j = 0; j < 4; ++j)
#pragma unroll
                  for (int i = 0; i < 4; ++i) { const int k = 256 * j + 4 * lane + i; hbuf[(size_t)m * D + k] = f2bf(v[4 * j + i] * inv * g[k]); } } }
#endif
        for (long i = gt; i < 48 * D; i += NT) { const int n = (int)(i / D), k = (int)(i % D);
            const float wv = (n < NEG) ? args.in[19][(size_t)k * NEG + n] : (n < NEG + NE) ? args.in[21][(size_t)k * NE + (n - NEG)] : 0.f;
            const bf16 hb = f2bf(wv); rwh[i] = hb; rwl[i] = f2bf(wv - bf2f(hb)); }
        const int tb0 = ((int)gridDim.x == 256) ? 64 : 0, tbn = (int)gridDim.x - tb0, tbi = (int)blockIdx.x - tb0;
        const long tfirst = tbi >= 0 ? (long)tid * tbn + tbi : (long)(1 << 30), tstep = (long)tbn * NTHREADS;
        for (long i = tfirst; i < NG * 4 * 64; i += tstep) { const int l = (int)(i & 63), t = (int)((i >> 6) & 3), g = (int)(i >> 8);
            { const int p = (t >> 1) * 32 + (l & 31), part = t & 1; const int gp = g * PS + p;
              const double are = (double)args.in[5][gp], aim = (double)args.in[6][gp], dt = dexp_((double)args.in[12][g]);
              double s, c; dsincos_(aim * dt, s, c); const double er = dexp_(are * dt); const double lr = er * c, li = er * s;
              const double nx = lr - 1.0, ny = li, den = are * are + aim * aim; const double cr = (nx * are + ny * aim) / den, ci = (ny * are - nx * aim) / den;
              unsigned wv[4];
#pragma unroll
              for (int i2 = 0; i2 < 4; ++i2) { float v2[2];
#pragma unroll
                  for (int q = 0; q < 2; ++q) { const int cc = 8 * (l >> 5) + 2 * i2 + q; const double br = (double)args.in[7][gp * GC + cc], bi = (double)args.in[8][gp * GC + cc];
                      v2[q] = part ? (float)(cr * bi + ci * br) : (float)(cr * br - ci * bi); }
                  wv[i2] = (unsigned)f2bf(v2[0]) | ((unsigned)f2bf(v2[1]) << 16); }
              u32x4 o; o.x = wv[0]; o.y = wv[1]; o.z = wv[2]; o.w = wv[3]; bbt[i] = o; }
            { const int ks = t, c = l & 15; unsigned wv[4];
#pragma unroll
              for (int i2 = 0; i2 < 4; ++i2) { float v2[2];
#pragma unroll
                  for (int q = 0; q < 2; ++q) { const int kk = ks * 32 + 8 * (l >> 4) + 2 * i2 + q; const int jj = kk >> 2, qq = kk & 3; const int p = jj + 32 * (qq >> 1);
                      v2[q] = (qq & 1) ? -args.in[10][(g * GC + c) * PS + p] : args.in[9][(g * GC + c) * PS + p]; }
                  wv[i2] = (unsigned)f2bf(v2[0]) | ((unsigned)f2bf(v2[1]) << 16); }
              u32x4 o; o.x = wv[0]; o.y = wv[1]; o.z = wv[2]; o.w = wv[3]; cmt[i] = o; } }
        for (long i = tfirst; i < NG * PS; i += tstep) { const int g = (int)(i / PS);
            const double are = (double)args.in[5][i], aim = (double)args.in[6][i], dt = dexp_((double)args.in[12][g]);
            double s, c; dsincos_(aim * dt, s, c); const double er = dexp_(are * dt); const double lr = er * c, li = er * s;
            lamb[i] = make_float2((float)lr, (float)li);
            double sL, cL; dsincos_(aim * dt * LSUB, sL, cL); const double eL = dexp_(are * dt * LSUB); lamL[i] = make_float2((float)(eL * cL), (float)(eL * sL));
            const double nx = lr - 1.0, ny = li, den = are * are + aim * aim; const double cr = (nx * are + ny * aim) / den, ci = (ny * are - nx * aim) / den;
#pragma unroll
            for (int cc = 0; cc < GC; ++cc) { const double br = (double)args.in[7][i * GC + cc], bi = (double)args.in[8][i * GC + cc];
                bbar[i * GC + cc] = make_float2((float)(cr * br - ci * bi), (float)(cr * bi + ci * br)); } }
    }

    GRID_BAR(0, 1);
#if FAST_P1
    if (IN(1)) {
        const bool split = (int)gridDim.x == 256;
        const int NGW = split ? CV_NGW : (int)gridDim.x;
        if ((int)blockIdx.x < NGW) {
            pg8::DenseSched S; S.so.init(M, INC, NGW, (int)blockIdx.x); S.A = (const char*)hbuf; S.B = (const char*)WinT; S.astep = (size_t)256 * D * 2; S.bstep = (size_t)256 * D * 2;
            S.nfull = (S.so.nwg / S.so.G) * S.so.G;
            pg8::EpiProj E{qkvu, gates, args.in[3]};
            pg8::gemm_phase<pg8::EpiProj, pg8::DenseSched, false, true>(ldsp, D, D, D, S, E, nullptr);
        }
        {   int tq = (int)threadIdx.x; asm volatile("" : "+v"(tq));
            const int lane = tq & 63, wave = __builtin_amdgcn_readfirstlane(tq >> 6), gw = (int)blockIdx.x * NWAVES + wave, NW = (int)gridDim.x * NWAVES;
            LAS float* scr = (LAS float*)(ldsp + wave * 8448);
            const int nsw = ((int)gridDim.x - NGW) * NWAVES;
            int done = CV_IN + CV_P0X;
            if (split) {
                if ((int)blockIdx.x >= NGW) { const int sw = ((int)blockIdx.x - NGW) * NWAVES + wave; cv_run(done + sw, nsw, CV_STREAM_J, scr, lane); }
                done += CV_STREAM_J * nsw;
            }
            if (split && CV_TAIL_J > 0) {
                const int nhalfw = 2 * (13 * 64 - (13 * 64 / NGW) * NGW), ntw = NGW - nhalfw;
                if ((int)blockIdx.x >= nhalfw && (int)blockIdx.x < NGW) cv_run(done + ((int)blockIdx.x - nhalfw) * NWAVES + wave, ntw * NWAVES, CV_TAIL_J, scr, lane);
                done += CV_TAIL_J * ntw * NWAVES;
            }
            cv_run(done + gw, NW, (CV_ALL - CV_P8X - done - gw + NW - 1) / NW, scr, lane);
        }
    }

#else
    if (IN(1)) {
        PH_IDX
        const float* bg = args.in[3];
        naive_gemm(hbuf, D, WinT, D, M, INC, D, [&](int m, int n, float acc) {
            if (n < QKVU_LD) qkvu[(size_t)m * QKVU_LD + n] = f2bf(acc);
            else gates[(size_t)m * GATEC + (n - QKVU_LD)] = f2bf(sigmoidf_(acc + bg[n - QKVU_LD])); }, gt, NT);
    }

#endif
    GRID_BAR(1, 2);
    if (IN(2)) {
        PH_IDX
#if FAST_ATT
#else
        const float* sinks = args.in[4];
        for (int task = gw; task < M * NH; task += NW) {
            const int h = task % NH, row = task / NH, t = row % SEQ, kvh = h / 4;
            const bf16* q = qkvu + (size_t)row * QKVU_LD + QOFF + h * HD;
            const float sink = sinks[h];
            const int t0 = t - lane, t1 = t - 64 - lane;
            float s0 = -3.0e38f, s1 = -3.0e38f;
            if (t0 >= 0) { const bf16* k = qkvu + (size_t)(row - lane) * QKVU_LD + KOFF + kvh * HD; float a = 0.f;
#pragma unroll
                for (int d8 = 0; d8 < 8; ++d8) a += dot8(*(const u32x4*)(q + 8 * d8), *(const u32x4*)(k + 8 * d8));
                s0 = a * 0.125f; }
            if (t1 >= 0) { const bf16* k = qkvu + (size_t)(row - 64 - lane) * QKVU_LD + KOFF + kvh * HD; float a = 0.f;
#pragma unroll
                for (int d8 = 0; d8 < 8; ++d8) a += dot8(*(const u32x4*)(q + 8 * d8), *(const u32x4*)(k + 8 * d8));
                s1 = a * 0.125f; }
            const float mx = fmaxf(wave_max(fmaxf(s0, s1)), sink);
            const float p0 = (t0 >= 0) ? __expf(s0 - mx) : 0.f, p1 = (t1 >= 0) ? __expf(s1 - mx) : 0.f;
            const float denom = wave_sum(p0 + p1) + __expf(sink - mx);
            float o = 0.f;
            for (int j = 0; j < 64; ++j) { const float pj = __shfl(p0, j); if (t - j >= 0) o += pj * bf2f(qkvu[(size_t)(row - j) * QKVU_LD + VOFF + kvh * HD + lane]); }
            for (int j = 0; j < 64; ++j) { const float pj = __shfl(p1, j); if (t - 64 - j >= 0) o += pj * bf2f(qkvu[(size_t)(row - 64 - j) * QKVU_LD + VOFF + kvh * HD + lane]); }
            attn[(size_t)row * DATT + h * HD + lane] = f2bf(o / denom);
        }
#endif
#if FAST_S5
        for (int un = (int)blockIdx.x; un < 256; un += (int)gridDim.x) {
            u32x4 kvreg[8]; att::load_kv(un, qkvu, kvreg);
            s5::run<false>(un, qkvu, bbt, cmt, lamb, lamL, sse, args.in[11], zbuf, ldsp);
            att::unit(un, qkvu, args.in[4], attn, ldsp, kvreg);
        }
#else
        const float* cre = args.in[9]; const float* cim = args.in[10]; const float* dsk = args.in[11];
        for (int bgi = gw; bgi < BATCH * NG; bgi += NW) {
            const int b = bgi / NG, g = bgi % NG;
            const float2 lam = lamb[g * PS + lane];
            float br[GC], bi[GC], cr[GC], ci[GC];
#pragma unroll
            for (int c = 0; c < GC; ++c) { const float2 bb = bbar[(g * PS + lane) * GC + c]; br[c] = bb.x; bi[c] = bb.y; cr[c] = cre[(g * GC + c) * PS + lane]; ci[c] = cim[(g * GC + c) * PS + lane]; }
            const float dmine = dsk[g * GC + (lane & 15)];
            float sr = 0.f, si = 0.f;
            for (int t = 0; t < SEQ; ++t) {
                const size_t row = (size_t)b * SEQ + t;
                const bf16* up = qkvu + row * QKVU_LD + UOFF + g * GC;
                const u32x4 ua = *(const u32x4*)up, ub = *(const u32x4*)(up + 8);
                float u[GC];
#pragma unroll
                for (int j = 0; j < 4; ++j) { u[2 * j] = __uint_as_float(ua[j] << 16); u[2 * j + 1] = __uint_as_float(ua[j] & 0xffff0000u); u[8 + 2 * j] = __uint_as_float(ub[j] << 16); u[8 + 2 * j + 1] = __uint_as_float(ub[j] & 0xffff0000u); }
                float bur = 0.f, bui = 0.f;
#pragma unroll
                for (int c = 0; c < GC; ++c) { bur += br[c] * u[c]; bui += bi[c] * u[c]; }
                const float nsr = lam.x * sr - lam.y * si + bur, nsi = lam.x * si + lam.y * sr + bui; sr = nsr; si = nsi;
                float ymine = 0.f, umine = 0.f;
#pragma unroll
                for (int c = 0; c < GC; ++c) { const float yc = wave_sum(cr[c] * sr - ci[c] * si); if ((lane & 15) == c) { ymine = yc; umine = u[c]; } }
                if (lane < GC) zbuf[row * DSSM + g * GC + lane] = f2bf(gelu_tanh(ymine + dmine * umine));
            }
        }
    #endif
    }
#if FAST_S5
    GRID_BAR(2, 3);
    if (IN(3)) {
        for (int un = (int)blockIdx.x; un < 256; un += (int)gridDim.x)
            s5::run<true>(un, qkvu, bbt, cmt, lamb, lamL, sse, args.in[11], zbuf, ldsp);
    }
#endif

    GRID_BAR(3, 4);
#if FAST_P4
    if (IN(4)) {
        pg8::DenseSched S; S.so.init(M, DSSM, (int)gridDim.x, (int)blockIdx.x); S.A = (const char*)zbuf; S.B = (const char*)WgluT; S.astep = (size_t)256 * DSSM * 2; S.bstep = (size_t)256 * DSSM * 2;
        S.nfull = 0;
        pg8::EpiGlu E{zbuf, zg, args.in[14]};
        pg8::gemm_phase<pg8::EpiGlu, pg8::DenseSched, false, true>(ldsp, DSSM, DSSM, DSSM, S, E, nullptr);
    }
#else
    if (IN(4)) {
        PH_IDX
        const float* bgl = args.in[14];
        naive_gemm(zbuf, DSSM, WgluT, DSSM, M, DSSM, DSSM, [&](int m, int n, float acc) {
            zg[(size_t)m * DSSM + n] = f2bf(bf2f(zbuf[(size_t)m * DSSM + n]) * sigmoidf_(acc + bgl[n])); }, gt, NT);
    }
#endif
    GRID_BAR(4, 5);
#if FAST_P5
    if (IN(5)) {
        pg8::BranchSched S; S.so.init(M, D, (int)gridDim.x, (int)blockIdx.x); S.A1 = (const char*)attn; S.B1 = (const char*)WaT; S.A2 = (const char*)zg; S.B2 = (const char*)WsT;
        pg8::EpiBranch2 E{gates, merged};
        pg8::gemm_phase<pg8::EpiBranch2, pg8::BranchSched, false, false, true>(ldsp, DSSM, DSSM, DSSM, S, E, nullptr);
    }
#else
    if (IN(5)) {
        PH_IDX
        for (long idx = gt; idx < (long)M * D; idx += NT) {
            const int m = (int)(idx / D), n = (int)(idx % D);
            const u32x4* a1 = (const u32x4*)(attn + (size_t)m * DATT); const u32x4* b1 = (const u32x4*)(WaT + (size_t)n * DATT);
            const u32x4* a2 = (const u32x4*)(zg + (size_t)m * DSSM); const u32x4* b2 = (const u32x4*)(WsT + (size_t)n * DSSM);
            float s1 = 0.f, s2 = 0.f;
#pragma unroll 4
            for (int k8 = 0; k8 < DATT / 8; ++k8) { s1 += dot8(a1[k8], b1[k8]); s2 += dot8(a2[k8], b2[k8]); }
            const float ga = bf2f(gates[(size_t)m * GATEC + n]), gs = bf2f(gates[(size_t)m * GATEC + D + n]);
            merged[idx] = f2bf(ga * s1 + gs * s2);
        }
    }
#endif
    GRID_BAR(5, 6);
#if FAST_P6
    if (IN(6)) {
        pg8::DenseSched S; S.so.init(M, D, (int)gridDim.x, (int)blockIdx.x); S.A = (const char*)merged; S.B = (const char*)WoutT; S.astep = (size_t)256 * D * 2; S.bstep = (size_t)256 * D * 2;
        pg8::EpiDelta E{delta};
        pg8::gemm_phase<pg8::EpiDelta, pg8::DenseSched, false>(ldsp, D, D, D, S, E, nullptr);
    }
#else
    if (IN(6)) {
        PH_IDX
        naive_gemm(merged, D, WoutT, D, M, D, D, [&](int m, int n, float acc) { out[(size_t)m * D + n] = x[(size_t)m * D + n] + acc; }, gt, NT);
    }
#endif
    GRID_BAR(6, 7);
#if FAST_P7
    if (IN(7)) {
        typedef short bf16x8_ __attribute__((ext_vector_type(8)));
        const int tid = threadIdx.x, lane = tid & 63, wave = __builtin_amdgcn_readfirstlane(tid >> 6), row = lane & 15, kg = lane >> 4;
        const float* g2 = args.in[18]; const float* brg = args.in[20]; const float* bre = args.in[22];
        LAS float* PL = (LAS float*)ldsp;
        LAS float* SSP = PL + 8 * 64 * 52;
        LAS float* RL = SSP + 8 * 4 * 64;
        LAS int* cntL = (LAS int*)(RL + 64 * 40); LAS int* baseL = cntL + 32;
        if (tid < NE) cntL[tid] = 0;
        for (int tg = (int)blockIdx.x; tg < M / 64; tg += (int)gridDim.x) {
#pragma unroll 1
            for (int half = 0; half < 2; ++half) {
                bf16x8_ wh[2][3], wl[2][3]; f32x4 ga[2], gb[2];
                const int kb = 128 * wave + 64 * half + 8 * kg;
#pragma unroll
                for (int s = 0; s < 2; ++s) { ga[s] = *(const f32x4*)(g2 + kb + 32 * s); gb[s] = *(const f32x4*)(g2 + kb + 32 * s + 4);
#pragma unroll
                    for (int nt = 0; nt < 3; ++nt) { const size_t wo = (size_t)(nt * 16 + row) * D + kb + 32 * s; wh[s][nt] = __builtin_bit_cast(bf16x8_, *(const u32x4*)(rwh + wo)); wl[s][nt] = __builtin_bit_cast(bf16x8_, *(const u32x4*)(rwl + wo)); } }
#pragma unroll 1
                for (int tile = 0; tile < 4; ++tile) {
                    const int m = tg * 64 + tile * 16 + row;
                    const float* xr = x + (size_t)m * D + kb; const bf16* dr = delta + (size_t)m * D + kb;
                    f32x4 xa[2], xb[2]; u32x4 dd[2];
#pragma unroll
                    for (int s = 0; s < 2; ++s) { xa[s] = __builtin_nontemporal_load((const f32x4*)(xr + 32 * s)); xb[s] = __builtin_nontemporal_load((const f32x4*)(xr + 32 * s + 4)); dd[s] = *(const u32x4*)(dr + 32 * s); }
                    LAS float* pl = PL + ((wave * 64) + tile * 16 + 4 * kg) * 52 + row;
                    f32x4 acc[3]; float ss = 0.f;
                    if (half) { ss = SSP[(wave * 4 + tile) * 64 + lane];
#pragma unroll
                        for (int nt = 0; nt < 3; ++nt)
#pragma unroll
                            for (int r = 0; r < 4; ++r) acc[nt][r] = pl[r * 52 + nt * 16]; }
                    else { acc[0] = (f32x4){0.f, 0.f, 0.f, 0.f}; acc[1] = acc[0]; acc[2] = acc[0]; }
#pragma unroll
                    for (int s = 0; s < 2; ++s) {
                        const f32x4 va = xa[s] + pg8::bflo4(dd[s].x, dd[s].y), vb = xb[s] + pg8::bflo4(dd[s].z, dd[s].w);
                        ss += va[0] * va[0] + va[1] * va[1] + va[2] * va[2] + va[3] * va[3] + vb[0] * vb[0] + vb[1] * vb[1] + vb[2] * vb[2] + vb[3] * vb[3];
                        const f32x4 ha = va * ga[s], hb = vb * gb[s];
                        u32x4 hw; hw.x = pg8::cvt_pk_bf16(ha[0], ha[1]); hw.y = pg8::cvt_pk_bf16(ha[2], ha[3]); hw.z = pg8::cvt_pk_bf16(hb[0], hb[1]); hw.w = pg8::cvt_pk_bf16(hb[2], hb[3]);
                        { u32x4 xw; xw.x = pg8::cvt_pk_bf16(va[0], va[1]); xw.y = pg8::cvt_pk_bf16(va[2], va[3]); xw.z = pg8::cvt_pk_bf16(vb[0], vb[1]); xw.w = pg8::cvt_pk_bf16(vb[2], vb[3]);
                          *(u32x4*)(h2u + (size_t)m * D + kb + 32 * s) = xw; }
                        u32x4 lw; lw.x = pg8::cvt_pk_bf16(ha[0] - __uint_as_float(hw.x << 16), ha[1] - __uint_as_float(hw.x & 0xffff0000u)); lw.y = pg8::cvt_pk_bf16(ha[2] - __uint_as_float(hw.y << 16), ha[3] - __uint_as_float(hw.y & 0xffff0000u));
                        lw.z = pg8::cvt_pk_bf16(hb[0] - __uint_as_float(hw.z << 16), hb[1] - __uint_as_float(hw.z & 0xffff0000u)); lw.w = pg8::cvt_pk_bf16(hb[2] - __uint_as_float(hw.w << 16), hb[3] - __uint_as_float(hw.w & 0xffff0000u));
                        const bf16x8_ ahi = __builtin_bit_cast(bf16x8_, hw), alo = __builtin_bit_cast(bf16x8_, lw);
#pragma unroll
                        for (int nt = 0; nt < 3; ++nt) {
                            acc[nt] = __builtin_amdgcn_mfma_f32_16x16x32_bf16(ahi, wh[s][nt], acc[nt], 0, 0, 0); mfma_keep(ahi, wh[s][nt], acc[nt][0]);
                            acc[nt] = __builtin_amdgcn_mfma_f32_16x16x32_bf16(alo, wh[s][nt], acc[nt], 0, 0, 0); mfma_keep(alo, wh[s][nt], acc[nt][0]);
                            acc[nt] = __builtin_amdgcn_mfma_f32_16x16x32_bf16(ahi, wl[s][nt], acc[nt], 0, 0, 0); mfma_keep(ahi, wl[s][nt], acc[nt][0]); }
                    }
                    SSP[(wave * 4 + tile) * 64 + lane] = ss;
#pragma unroll
                    for (int nt = 0; nt < 3; ++nt)
#pragma unroll
                        for (int r = 0; r < 4; ++r) pl[r * 52 + nt * 16] = acc[nt][r];
                }
            }
            __syncthreads();
#pragma unroll 1
            for (int idx = tid; idx < 64 * 37; idx += NTHREADS) { const int tok = idx / 37, i = idx - tok * 37; float sacc = 0.f;
                if (i < 36) {
#pragma unroll
                    for (int w8 = 0; w8 < 8; ++w8) sacc += PL[(w8 * 64 + tok) * 52 + i]; }
                else {
#pragma unroll
                    for (int w8 = 0; w8 < 8; ++w8)
#pragma unroll
                        for (int q4 = 0; q4 < 4; ++q4) sacc += SSP[(w8 * 4 + (tok >> 4)) * 64 + q4 * 16 + (tok & 15)]; }
                RL[tok * 40 + i] = sacc; }
            __syncthreads();
            int tq = (int)threadIdx.x; asm volatile("" : "+v"(tq));
            const bool router_lane = tq < 64; const int mt = tg * 64 + (tq & 63);
            int ex0 = 0, ex1 = 0, rk0 = 0, rk1 = 0; float w0 = 0.f, w1 = 0.f, inv = 0.f;
            if (router_lane) {
                const int tok = tq;
                inv = 1.f / sqrtf(RL[tok * 40 + 36] * (1.f / D) + EPS);
                float lg[36];
#pragma unroll
                for (int i = 0; i < 36; ++i) lg[i] = RL[tok * 40 + i] * inv;
                float gl[4];
#pragma unroll
                for (int i = 0; i < 4; ++i) gl[i] = lg[i] + brg[i];
                int gi = 0; float gm = gl[0];
#pragma unroll
                for (int i = 1; i < 4; ++i) if (gl[i] > gm) { gm = gl[i]; gi = i; }
                float gsum = 0.f;
#pragma unroll
                for (int i = 0; i < 4; ++i) gsum += __expf(gl[i] - gm);
                const float group_p = 1.f / gsum;
                float sel[8];
#pragma unroll
                for (int i = 0; i < 8; ++i) { float sv = 0.f;
#pragma unroll
                    for (int q = 0; q < 4; ++q) if (gi == q) sv = lg[4 + 8 * q + i] + bre[8 * q + i];
                    sel[i] = sv; }
                int i0 = 0; float m0 = sel[0];
#pragma unroll
                for (int i = 1; i < 8; ++i) if (sel[i] > m0) { m0 = sel[i]; i0 = i; }
                int i1 = -1; float m1 = -3.0e38f;
#pragma unroll
                for (int i = 0; i < 8; ++i) if (i != i0 && sel[i] > m1) { m1 = sel[i]; i1 = i; }
                const float e1 = __expf(m1 - m0);
                w0 = group_p / (1.f + e1); w1 = group_p * e1 / (1.f + e1);
                ex0 = gi * EPG + i0; ex1 = gi * EPG + i1;
                rk0 = __hip_atomic_fetch_add(&cntL[ex0], 1, __ATOMIC_RELAXED, __HIP_MEMORY_SCOPE_WORKGROUP); rk1 = __hip_atomic_fetch_add(&cntL[ex1], 1, __ATOMIC_RELAXED, __HIP_MEMORY_SCOPE_WORKGROUP);
            }
            __syncthreads();
            if (tq < NE) { const int c = cntL[tq]; baseL[tq] = c ? (int)atomicAdd(&ecnt[64 * tq], (unsigned)c) : 0; cntL[tq] = 0; }
            __syncthreads();
            if (router_lane) {
                const int sl0 = baseL[ex0] + rk0, sl1 = baseL[ex1] + rk1;
                lists[(size_t)ex0 * M + sl0] = 2 * mt; lists[(size_t)ex1 * M + sl1] = 2 * mt + 1;
                tok_e[2 * mt] = ex0; tok_e[2 * mt + 1] = ex1; tok_slot[2 * mt] = sl0; tok_slot[2 * mt + 1] = sl1; tok_w[2 * mt] = w0; tok_w[2 * mt + 1] = w1; tok_inv[mt] = inv;
            }
        }
    }
#else
    if (IN(7)) {
        PH_IDX
        const float* g2 = args.in[18]; const float* wrg = args.in[19]; const float* brg = args.in[20]; const float* wre = args.in[21]; const float* bre = args.in[22];
        for (int m = gw; m < M; m += NW) {
            const float* xr = out + (size_t)m * D; float ss = 0.f;
#pragma unroll
            for (int j = 0; j < 4; ++j) { const f32x4 t = *(const f32x4*)(xr + 256 * j + 4 * lane); ss += t[0] * t[0] + t[1] * t[1] + t[2] * t[2] + t[3] * t[3]; }
            const float inv = 1.f / sqrtf(wave_sum(ss) * (1.f / D) + EPS);
            float lg[36];
#pragma unroll
            for (int i = 0; i < 36; ++i) lg[i] = 0.f;
#pragma unroll 1
            for (int kk = 0; kk < 16; ++kk) { const int k = 256 * (kk >> 2) + 4 * lane + (kk & 3); const float hv = xr[k] * g2[k]; h2u[(size_t)m * D + k] = f2bf(hv); const float hn = hv * inv;
                const f32x4 w4 = *(const f32x4*)(wrg + (size_t)k * NEG); lg[0] += hn * w4[0]; lg[1] += hn * w4[1]; lg[2] += hn * w4[2]; lg[3] += hn * w4[3];
#pragma unroll
                for (int q = 0; q < 8; ++q) { const f32x4 w = *(const f32x4*)(wre + (size_t)k * NE + 4 * q); lg[4 + 4 * q] += hn * w[0]; lg[5 + 4 * q] += hn * w[1]; lg[6 + 4 * q] += hn * w[2]; lg[7 + 4 * q] += hn * w[3]; } }
#pragma unroll
            for (int i = 0; i < 36; ++i) lg[i] = wave_sum(lg[i]);
            float gl[4];
#pragma unroll
            for (int i = 0; i < 4; ++i) gl[i] = lg[i] + brg[i];
            int gi = 0; float gm = gl[0];
#pragma unroll
            for (int i = 1; i < 4; ++i) if (gl[i] > gm) { gm = gl[i]; gi = i; }
            float gsum = 0.f;
#pragma unroll
            for (int i = 0; i < 4; ++i) gsum += __expf(gl[i] - gm);
            const float group_p = 1.f / gsum;
            float sel[8];
#pragma unroll
            for (int i = 0; i < 8; ++i) { float s = 0.f;
#pragma unroll
                for (int q = 0; q < 4; ++q) if (gi == q) s = lg[4 + 8 * q + i] + bre[8 * q + i];
                sel[i] = s; }
            int i0 = 0; float m0 = sel[0];
#pragma unroll
            for (int i = 1; i < 8; ++i) if (sel[i] > m0) { m0 = sel[i]; i0 = i; }
            int i1 = -1; float m1 = -3.0e38f;
#pragma unroll
            for (int i = 0; i < 8; ++i) if (i != i0 && sel[i] > m1) { m1 = sel[i]; i1 = i; }
            const float e1 = __expf(m1 - m0);
            const float w0 = group_p / (1.f + e1), w1 = group_p * e1 / (1.f + e1);
            if (lane == 0) {
                const int ex0 = gi * EPG + i0, ex1 = gi * EPG + i1;
                const int sl0 = (int)atomicAdd(&ecnt[64 * ex0], 1u), sl1 = (int)atomicAdd(&ecnt[64 * ex1], 1u);
                lists[(size_t)ex0 * M + sl0] = 2 * m; lists[(size_t)ex1 * M + sl1] = 2 * m + 1;
                tok_e[2 * m] = ex0; tok_e[2 * m + 1] = ex1; tok_slot[2 * m] = sl0; tok_slot[2 * m + 1] = sl1; tok_w[2 * m] = w0; tok_w[2 * m + 1] = w1; tok_inv[m] = inv;
            }
        }
    }
#endif
    GRID_BAR(7, 8);
#if FAST_MOE
#define MOE_SETUP(PH8) \
        const int tid = threadIdx.x; \
        LAS int* ttab = (LAS int*)(ldsp + LDS_TILETAB); LAS int* cntl = (LAS int*)(ldsp + LDS_MISC); LAS int* rbase = (LAS int*)(ldsp + LDS_MISC + 256); LAS int* rowtab = (LAS int*)(ldsp + LDS_ROWTAB); \
        __syncthreads(); \
        if (tid < NE) cntl[tid] = (int)ecnt[64 * tid]; \
        __syncthreads(); \
        if (tid < 33) { int s = 0; for (int q = 0; q < tid; ++q) s += cntl[q]; rbase[tid] = s; } \
        if (tid >= 64 && tid < 64 + NE) { const int q = tid - 64; const int c = cntl[q], nf = c >> 8, rem_ = c & 255; int fb = 0, tot = 0, rank = 0, nrag = 0; \
            for (int q2 = 0; q2 < NE; ++q2) { const int c2 = cntl[q2], nf2 = c2 >> 8, rem2 = c2 & 255; tot += nf2; if (q2 < q) fb += nf2; \
                if (rem2 > 0) { ++nrag; if (rem2 > rem_ || (rem2 == rem_ && q2 < q)) ++rank; } } \
            for (int r_ = 0; r_ < nf; ++r_) ttab[fb + r_] = (q << 8) | r_; \
            if (rem_) ttab[tot + rank] = (q << 8) | nf; \
            if (q == 0) ttab[160] = tot + nrag; } \
        __syncthreads(); \
        pg8::MoeSched S; S.tpre = ttab; S.rbase = rbase; S.U = 4 * ttab[160]; S.G = (int)gridDim.x; S.c = (int)blockIdx.x; \
        if (PH8) { S.A = (const char*)h2u; S.B = (const char*)WguT; S.bstepE = (size_t)1024 * D * 2; S.bstepN = (size_t)256 * D * 2; S.arow = 0; S.gather = true; } \
        else { S.A = (const char*)act; S.B = (const char*)WdT; S.bstepE = (size_t)D * DFF * 2; S.bstepN = (size_t)256 * DFF * 2; S.arow = (size_t)DFF * 2; S.gather = false; } \
        { const int hf_ = tid >> 8, r_ = tid & 255; pg8::Unit ua_, ub_; const bool ha_ = S.next(hf_, ua_), hb_ = S.next(2 + hf_, ub_);     \
          int ea_ = 0, eb_ = 0; float va_ = 0.f, vb_ = 0.f; \
          if (ha_) ea_ = lists[(size_t)ua_.aux * M + ua_.rt * 256 + (r_ < ua_.nrows ? r_ : 0)]; \
          if (hb_) eb_ = lists[(size_t)ub_.aux * M + ub_.rt * 256 + (r_ < ub_.nrows ? r_ : 0)]; \
          if (ha_) va_ = (PH8) ? tok_inv[ea_ >> 1] : tok_w[ea_]; \
          if (hb_) vb_ = (PH8) ? tok_inv[eb_ >> 1] : tok_w[eb_]; \
          if (ha_) { rowtab[2 * (hf_ * 256 + r_)] = (PH8) ? (ea_ >> 1) : ea_; rowtab[2 * (hf_ * 256 + r_) + 1] = __float_as_int(va_); } \
          if (hb_) { rowtab[2 * ((2 + hf_) * 256 + r_)] = (PH8) ? (eb_ >> 1) : eb_; rowtab[2 * ((2 + hf_) * 256 + r_) + 1] = __float_as_int(vb_); } } \
        __syncthreads();
    if (IN(8)) { MOE_SETUP(true)
        pg8::EpiAct E{act, rowtab}; pg8::gemm_phase<pg8::EpiAct, pg8::MoeSched, true, true>(ldsp, D, D, D, S, E, rowtab);
        {
            int tq = (int)threadIdx.x; asm volatile("" : "+v"(tq));
            const int lane = tq & 63, wave = __builtin_amdgcn_readfirstlane(tq >> 6);
            const int ntl = ttab[160], c = (int)blockIdx.x;
            int nidleq = 64 * ((ntl + 63) / 64) - ntl, rank = c, npart = (int)gridDim.x;
            if ((int)gridDim.x == 256 && nidleq > 0) { const int q = (c & 7) * 8 + (c >> 5); rank = (q - (64 - nidleq)) * 4 + ((c >> 3) & 3); npart = 4 * nidleq; if (q < 64 - nidleq) rank = -1; }
            if (rank >= 0) { const int first = CV_ALL - CV_P8X + rank * NWAVES + wave, stride = npart * NWAVES;
                cv_run(first, stride, (CV_ALL - first + stride - 1) / stride, (LAS float*)(ldsp + wave * 8448), lane); }
        } }
    XbTicket tk89; tk89.mode = 0u; tk89.val = 0u;
    if (BOTH(8, 9)) tk89 = xcd_barrier_arrive(gbar);
    if (IN(9)) { MOE_SETUP(false)
        if (BOTH(8, 9)) xcd_barrier_wait(gbar, tk89);
        pg8::EpiDown E{contrib, rowtab}; pg8::gemm_phase<pg8::EpiDown, pg8::MoeSched, false, true>(ldsp, DFF, DFF, DFF, S, E, rowtab); }
    else if (BOTH(8, 9)) xcd_barrier_wait(gbar, tk89);
#else
    if (IN(8)) {
        PH_IDX
        for (long idx = gt; idx < (long)2 * M * DFF; idx += NT) {
            const int pos = (int)(idx / DFF), j = (int)(idx % DFF);
            int e = 0, base = 0;
            for (int q = 0; q < NE; ++q) { const int c = (int)ecnt[64 * q]; if (pos >= base + c) { base += c; e = q + 1; } else break; }
            const int ent = lists[(size_t)e * M + (pos - base)]; const int tok = ent >> 1;
            const float inv = tok_inv[tok];
            const u32x4* a = (const u32x4*)(h2u + (size_t)tok * D);
            const int np = 256 * (j >> 7) + (j & 127);
            const u32x4* bgp = (const u32x4*)(WguT + ((size_t)e * 1024 + np) * D); const u32x4* bup = (const u32x4*)(WguT + ((size_t)e * 1024 + np + 128) * D);
            float sg = 0.f, su = 0.f;
#pragma unroll 4
            for (int k8 = 0; k8 < D / 8; ++k8) { const u32x4 av = a[k8]; sg += dot8(av, bgp[k8]); su += dot8(av, bup[k8]); }
            sg *= inv; su *= inv;
            act[(size_t)pos * DFF + j] = f2bf(sg * sigmoidf_(sg) * su);
        }
    }
    GRID_BAR(8, 9);
    if (IN(9)) {
        PH_IDX
        for (long idx = gt; idx < (long)2 * M * D; idx += NT) {
            const int pos = (int)(idx / D), n = (int)(idx % D);
            int e = 0, base = 0;
            for (int q = 0; q < NE; ++q) { const int c = (int)ecnt[64 * q]; if (pos >= base + c) { base += c; e = q + 1; } else break; }
            const int ent = lists[(size_t)e * M + (pos - base)]; const int tok = ent >> 1, kk = ent & 1;
            const u32x4* a = (const u32x4*)(act + (size_t)pos * DFF); const u32x4* b = (const u32x4*)(WdT + ((size_t)e * D + n) * DFF);
            float s = 0.f;
#pragma unroll 4
            for (int k8 = 0; k8 < DFF / 8; ++k8) s += dot8(a[k8], b[k8]);
            contrib[((size_t)kk * M + tok) * D + n] = f2bf(s * tok_w[2 * tok + kk]);
        }
    }
#endif
    GRID_BAR(9, 10);
#if FAST_P10
    if (IN(10)) {
        PH_IDX
        const float* gf = args.in[26]; f32x4 gv[4];
#pragma unroll
        for (int j = 0; j < 4; ++j) gv[j] = *(const f32x4*)(gf + 256 * j + 4 * lane);
        typedef unsigned u32x2_ __attribute__((ext_vector_type(2)));
        u32x2_ xn[4], c0n[4], c1n[4];
#define P10_LOAD(mm) do { _Pragma("unroll") for (int j = 0; j < 4; ++j) { const size_t off = (size_t)(mm) * D + 256 * j + 4 * lane; \
            xn[j] = *(const u32x2_*)(h2u + off); c0n[j] = *(const u32x2_*)(contrib + off); c1n[j] = *(const u32x2_*)(contrib + (size_t)M * D + off); } } while (0)
        if (gw < M) P10_LOAD(gw);
#pragma unroll 1
        for (int m = gw; m < M; m += NW) {
            f32x4 v[4]; float ss = 0.f;
#pragma unroll
            for (int j = 0; j < 4; ++j) v[j] = pg8::bflo4(xn[j].x, xn[j].y) + pg8::bflo4(c0n[j].x, c0n[j].y) + pg8::bflo4(c1n[j].x, c1n[j].y);
            if (m + NW < M) P10_LOAD(m + NW);
#pragma unroll
            for (int j = 0; j < 4; ++j) ss += v[j][0] * v[j][0] + v[j][1] * v[j][1] + v[j][2] * v[j][2] + v[j][3] * v[j][3];
            const float inv = 1.f / sqrtf(wave_sum(ss) * (1.f / D) + EPS);
#pragma unroll
            for (int j = 0; j < 4; ++j) *(f32x4*)(out + (size_t)m * D + 256 * j + 4 * lane) = v[j] * inv * gv[j];
        }
    }
#else
    if (IN(10)) {
        PH_IDX
        const float* gf = args.in[26];
        for (int m = gw; m < M; m += NW) {
            float v[16]; float ss = 0.f;
#pragma unroll
            for (int j = 0; j < 4; ++j)
#pragma unroll
                for (int i = 0; i < 4; ++i) { const int k = 256 * j + 4 * lane + i; const float t = out[(size_t)m * D + k] + bf2f(contrib[(size_t)m * D + k]) + bf2f(contrib[((size_t)M + m) * D + k]); v[4 * j + i] = t; ss += t * t; }
            const float inv = 1.f / sqrtf(wave_sum(ss) * (1.f / D) + EPS);
#pragma unroll
            for (int j = 0; j < 4; ++j)
#pragma unroll
                for (int i = 0; i < 4; ++i) { const int k = 256 * j + 4 * lane + i; out[(size_t)m * D + k] = v[4 * j + i] * inv * gf[k]; }
        }
    }
#endif
#undef IN
}

extern "C" void kernel_launch(void* const* d_in, const int* in_sizes, int n_in, void* d_out, int out_size, void* d_ws, size_t ws_size, hipStream_t stream) {
    static int grid = 0;
    if (grid == 0) {
        if (n_in != 27 || out_size != M * D || ws_size < WS_END) { fprintf(stderr, "kernel_launch: unexpected shapes (n_in %d out %d ws %zu)\n", n_in, out_size, ws_size); grid = -1; return; }
        int dev = 0, cus = 0;
        if (hipGetDevice(&dev) != hipSuccess || hipDeviceGetAttribute(&cus, hipDeviceAttributeMultiprocessorCount, dev) != hipSuccess) { grid = -1; return; }
        if (hipFuncSetAttribute((const void*)fwd, hipFuncAttributeMaxDynamicSharedMemorySize, LDS_BYTES) != hipSuccess) { grid = -1; return; }
        grid = cus;
    }
    if (grid < 0) return;
    (void)hipMemsetAsync((char*)d_ws + WS_CTL, 0, CTL_ZERO_BYTES, stream);
    Args a{};
    for (int i = 0; i < 27; ++i) a.in[i] = (const float*)d_in[i];
    a.out = (float*)d_out; a.ws = (unsigned char*)d_ws;
#if defined(PROBE_PH)
    a.ph_lo = 0; a.ph_hi = PROBE_PH + 1;
    hipLaunchKernelGGL(fwd, dim3(grid), dim3(NTHREADS), LDS_BYTES, stream, a);
    (void)hipMemsetAsync((char*)d_ws + WS_CTL + CW_BAR * 4, 0, XCD_BAR_WORDS * 4, stream);
    (void)hipMemsetAsync((char*)d_ws + WS_CTL + CW_CNT * 4, 0, 2048 * 4, stream);
    a.ph_lo = PROBE_PH; a.ph_hi = NPH;
    hipLaunchKernelGGL(fwd, dim3(grid), dim3(NTHREADS), LDS_BYTES, stream, a);
#elif MK_N_LAUNCHES == 1
    a.ph_lo = 0; a.ph_hi = NPH;
    hipLaunchKernelGGL(fwd, dim3(grid), dim3(NTHREADS), LDS_BYTES, stream, a);
#else
    for (int p = 0; p < NPH; ++p) {
        a.ph_lo = p; a.ph_hi = p + 1;
        hipLaunchKernelGGL(fwd, dim3(grid), dim3(NTHREADS), LDS_BYTES, stream, a);
    }
#endif
}
```

```cpp
#include <hip/hip_runtime.h>
#include <cstdio>
#include <cstdint>

constexpr int BATCH = 2, SEQ = 8192, D = 1024, M = BATCH * SEQ;
constexpr int DSSM = 512, NG = 32, GC = 16, PS = 64;
constexpr int HD = 64, NH = 8, NKV = 2, DATT = 512, WIN = 128;
constexpr int INC = 3328, GATEC = 2048;
constexpr int NEG = 4, EPG = 8, NE = 32, DFF = 512;
constexpr int QKVU_LD = 1280;
constexpr int QOFF = 0, KOFF = 512, VOFF = 640, UOFF = 768;
constexpr float EPS = 1e-6f;
constexpr int LSUB = 128;
constexpr int NSUB = SEQ / LSUB;

constexpr size_t MiB = 1u << 20;
constexpr size_t WS_CTL = 0, CTL_ZERO_BYTES = 1 * MiB;
constexpr size_t WS_PAR = 1 * MiB;
constexpr size_t WS_SSE = 2 * MiB;
constexpr size_t WS_LIST = 4 * MiB;
constexpr size_t WS_TOK = 253 * MiB;
constexpr size_t WS_WIN = 8 * MiB;
constexpr size_t WS_WGLU = 15 * MiB;
constexpr size_t WS_WA = 16 * MiB;
constexpr size_t WS_WS = 17 * MiB;
constexpr size_t WS_WOUT = 18 * MiB;
constexpr size_t WS_WGU = 20 * MiB;
constexpr size_t WS_WD = 84 * MiB;
constexpr size_t WS_R1 = 116 * MiB;
constexpr size_t WS_GATES = 149 * MiB;
constexpr size_t WS_QKVU = 213 * MiB;
constexpr size_t WS_END = 254 * MiB;
constexpr size_t DO_ATTN = 0, DO_Z = 16 * MiB, DO_ZG = 32 * MiB;

constexpr int CW_TMO = 0;
constexpr int CW_CNT = 1024;
constexpr int CW_BAR = 4096;
constexpr int CW_ROWSS = 16384;

constexpr size_t PAR_LAMB = 0;
constexpr size_t PAR_LAML = 16384;
constexpr size_t PAR_BBAR = 32768;
constexpr size_t PAR_BBT = PAR_BBAR + 32 * 64 * 16 * 8;
constexpr size_t PAR_CMT = PAR_BBT + 32 * 4 * 64 * 16;
constexpr size_t PAR_END = PAR_CMT + 32 * 4 * 64 * 16;
constexpr size_t PAR_RWH = PAR_END;
constexpr size_t PAR_RWL = PAR_RWH + 48 * 1024 * 2;
constexpr size_t PAR_END2 = PAR_RWL + 48 * 1024 * 2;
static_assert(PAR_END2 <= MiB, "PAR region");

constexpr size_t TOK_E = 0;
constexpr size_t TOK_SLOT = 128 * 1024;
constexpr size_t TOK_W = 256 * 1024;
constexpr size_t TOK_INV = 384 * 1024;

constexpr int NWAVES = 8;
constexpr int NTHREADS = NWAVES * 64;
constexpr int LDS_BYTES = 147456;
constexpr int LDS_MISC = 131072;
constexpr int LDS_TILETAB = LDS_MISC + 640;
constexpr int LDS_ROWTAB = LDS_MISC + 2048;
constexpr int LDS_BARW = LDS_MISC + 512;
constexpr int NPH = 11;
#ifndef CV_STREAM_J
#define CV_STREAM_J 22
#endif
#ifndef CV_NGW
#define CV_NGW 208
#endif
#ifndef CV_TAIL_J
#define CV_TAIL_J 0
#endif
#ifndef CV_P8X
#define CV_P8X 8192
#endif
#ifndef CV_P0X
#define CV_P0X 9088
#endif
#ifndef FAST_P1
#define FAST_P1 1
#endif
#ifndef FAST_P4
#define FAST_P4 1
#endif
#ifndef FAST_P5
#define FAST_P5 1
#endif
#ifndef FAST_P6
#define FAST_P6 1
#endif
#ifndef FAST_P0
#define FAST_P0 1
#endif
#ifndef FAST_P10
#define FAST_P10 1
#endif
#ifndef FAST_ATT
#define FAST_ATT 1
#endif
#ifndef FAST_P7
#define FAST_P7 1
#endif
#ifndef FAST_S5
#define FAST_S5 1
#endif
#ifndef FAST_MOE
#define FAST_MOE 1
#endif
#ifndef MK_N_LAUNCHES
#define MK_N_LAUNCHES 1
#endif

typedef unsigned short bf16;
typedef float f32x4 __attribute__((ext_vector_type(4)));
typedef unsigned u32x4 __attribute__((ext_vector_type(4)));


typedef short kbf16x8 __attribute__((ext_vector_type(8)));
__device__ __forceinline__ void mfma_keep(kbf16x8 a, kbf16x8 b, float r0) {
    const u32x4 au = __builtin_bit_cast(u32x4, a), bu = __builtin_bit_cast(u32x4, b);
    asm volatile("" :: "v"(au.x), "v"(au.y), "v"(au.z), "v"(au.w), "v"(bu.x), "v"(bu.y), "v"(bu.z), "v"(bu.w), "v"(r0));
}
__device__ __forceinline__ float opq(float x) { asm volatile("" : "+v"(x)); return x; }
__device__ __forceinline__ float bf2f(bf16 b) { return __uint_as_float(((unsigned)b) << 16); }
__device__ __forceinline__ bf16 f2bf(float f) { unsigned u = __float_as_uint(f); return (bf16)((u + 0x7fffu + ((u >> 16) & 1u)) >> 16); }
__device__ __forceinline__ float wave_sum(float v) {
#pragma unroll
    for (int o = 1; o < 64; o <<= 1) v += __shfl_xor(v, o);
    return v;
}
__device__ __forceinline__ float wave_max(float v) {
#pragma unroll
    for (int o = 1; o < 64; o <<= 1) v = fmaxf(v, __shfl_xor(v, o));
    return v;
}
__device__ __forceinline__ float dot8(u32x4 a, u32x4 b) {
    float s = 0.f;
#pragma unroll
    for (int j = 0; j < 4; ++j) {
        s += __uint_as_float(a[j] << 16) * __uint_as_float(b[j] << 16);
        s += __uint_as_float(a[j] & 0xffff0000u) * __uint_as_float(b[j] & 0xffff0000u);
    }
    return s;
}
__device__ __forceinline__ float sigmoidf_(float x) { return 1.f / (1.f + __expf(-x)); }
__device__ __forceinline__ float gelu_tanh(float x) {
    const float u = 0.7978845608028654f * (x + 0.044715f * x * x * x);
    const float e = __expf(2.f * u);
    const float th = 1.f - 2.f / (e + 1.f);
    return 0.5f * x * (1.f + th);
}

__device__ __forceinline__ double dexp_(double x) {
    const double k = rint(x * 1.4426950408889634);
    const double r = fma(-k, 1.9082149292705877e-10, fma(-k, 0.6931471803691238, x));
    double p = 1.0 / 6227020800.0;
    p = fma(p, r, 1.0 / 479001600.0); p = fma(p, r, 1.0 / 39916800.0); p = fma(p, r, 1.0 / 3628800.0); p = fma(p, r, 1.0 / 362880.0);
    p = fma(p, r, 1.0 / 40320.0); p = fma(p, r, 1.0 / 5040.0); p = fma(p, r, 1.0 / 720.0); p = fma(p, r, 1.0 / 120.0);
    p = fma(p, r, 1.0 / 24.0); p = fma(p, r, 1.0 / 6.0); p = fma(p, r, 0.5); p = fma(p, r, 1.0); p = fma(p, r, 1.0);
    const long long e = (long long)k + 1023;
    return p * __longlong_as_double(e << 52);
}
__device__ __forceinline__ void dsincos_(double x, double& s, double& c) {
    const double k = rint(x * 0.6366197723675814);
    const double r = fma(-k, 6.123233995736766e-17, fma(-k, 1.5707963267948966, x));
    const double r2 = r * r;
    double sp = -1.0 / 1307674368000.0;
    sp = fma(sp, r2, 1.0 / 6227020800.0); sp = fma(sp, r2, -1.0 / 39916800.0); sp = fma(sp, r2, 1.0 / 362880.0);
    sp = fma(sp, r2, -1.0 / 5040.0); sp = fma(sp, r2, 1.0 / 120.0); sp = fma(sp, r2, -1.0 / 6.0); sp = fma(sp * r2, r, r);
    double cp = 1.0 / 20922789888000.0;
    cp = fma(cp, r2, -1.0 / 87178291200.0); cp = fma(cp, r2, 1.0 / 479001600.0); cp = fma(cp, r2, -1.0 / 3628800.0);
    cp = fma(cp, r2, 1.0 / 40320.0); cp = fma(cp, r2, -1.0 / 720.0); cp = fma(cp, r2, 1.0 / 24.0); cp = fma(cp, r2, -0.5); cp = fma(cp, r2, 1.0);
    const int q = ((int)k) & 3;
    s = (q == 0) ? sp : (q == 1) ? cp : (q == 2) ? -sp : -cp;
    c = (q == 0) ? cp : (q == 1) ? -sp : (q == 2) ? -cp : sp;
}


#define LAS __attribute__((address_space(3)))
namespace pg8 {
typedef short bf16x8 __attribute__((ext_vector_type(8)));
constexpr int BM = 256, BK = 64, HALF = 128, HTB = HALF * BK * 2, STAGE_BYTES = 8 * HTB, NXCD = 8, WGM = 8;
__device__ __forceinline__ int lds_byte(int r, int c) { const int st = (r >> 4) * 2 + (c >> 5), rr = r & 15, cc = c & 31, ob = rr * 64 + cc * 2; return st * 1024 + (ob ^ (((ob >> 9) & 1) << 5)); }
__device__ __forceinline__ void stage_rc(int b, int& R, int& C) { const int st = b / 1024, sb = b % 1024, swz = sb ^ (((sb >> 9) & 1) << 5); R = (st >> 1) * 16 + swz / 64; C = (st & 1) * 32 + (swz % 64) / 2; }
__device__ __forceinline__ int perm32(int rho) { const int n = rho >> 4, i = rho & 15; return 8 * (i >> 2) + 4 * n + (i & 3); }
typedef float f32x2_t __attribute__((ext_vector_type(2)));
typedef __bf16 bf16x2_t __attribute__((ext_vector_type(2)));
__device__ __forceinline__ unsigned cvt_pk_bf16(float lo, float hi) { const f32x2_t v = {lo, hi}; const bf16x2_t b = __builtin_convertvector(v, bf16x2_t); return __builtin_bit_cast(unsigned, b); }

struct Unit { const char* a; const char* b; int row0, col0, nrows, aux, rt; };

struct StaticOrder {
    int nM, nN, nwg, G, c;
    __device__ void init(int Mr, int N, int G_, int c_) { nM = Mr / BM; nN = N / BM; nwg = nM * nN; G = G_; c = c_; }
    __device__ bool next(int i, int& pm, int& pn) const { return at((long)i * G + c, pm, pn); }
    __device__ bool at(const long L, int& pm, int& pn) const {
        if (L >= nwg) return false;
        int wgid = (int)L; { const int q = nwg / NXCD, r = nwg % NXCD, xcd = wgid % NXCD, off = wgid / NXCD; wgid = (xcd < r ? xcd * (q + 1) : r * (q + 1) + (xcd - r) * q) + off; }
        const int nig = WGM * nN, gid = wgid / nig, fm = gid * WGM, gsz = (nM - fm) < WGM ? (nM - fm) : WGM;
        pm = fm + ((wgid % nig) % gsz); pn = (wgid % nig) / gsz; return true;
    }
};
struct DenseSched {
    StaticOrder so; const char* A; const char* B; size_t astep, bstep;
    int nfull = 1 << 30;
    __device__ bool next(int i, Unit& u) const {
        const long L = (long)i * so.G + so.c; int pm, pn; int half = -1; long Lu = L;
        if (L >= nfull) { const long hl = L - nfull; Lu = nfull + (hl >> 1); half = (int)(hl & 1); }
        if (!so.at(Lu, pm, pn)) return false;
        u.a = A + (size_t)pm * astep; u.b = B + (size_t)pn * bstep; u.row0 = pm * BM; u.col0 = pn * BM; u.nrows = BM; u.aux = 0; u.rt = 0;
        if (half >= 0) { u.nrows = HALF; if (half) { u.a += astep / 2; u.row0 += HALF; } }
        return true; }
};

template <class Epi, class Sched, bool GATHER, bool GATHER_OR_RAGGED = false, bool CARRY_ACC = false>
__device__ __forceinline__ void gemm_phase(LAS unsigned char* lds, const int K, const int lda, const int ldb, const Sched& S, const Epi& E, const LAS int* rowtab) {
    const int tid = threadIdx.x, wid = __builtin_amdgcn_readfirstlane(tid >> 6), lane = tid & 63, wr = wid >> 2, wc = wid & 3, fr = lane & 15, fq = lane >> 4;
    const int nt = K / BK;
    unsigned voffA[2][2], voffB[2];
#pragma unroll
    for (int i = 0; i < 2; ++i) { int R, C; stage_rc(tid * 16 + i * 8192, R, C); const int Rb = Epi::PERM ? ((R & ~31) + perm32(R & 31)) : R;
        voffB[i] = (unsigned)(Rb * ldb + C) * 2u;
        voffA[0][i] = (unsigned)(R * lda + C) * 2u; voffA[1][i] = (unsigned)((R + HALF) * lda + C) * 2u; }
    const size_t kstep = (size_t)(BK * 2);
    const size_t hstepB = (size_t)HALF * ldb * 2;
    const unsigned ldsw = (unsigned)wid * 1024u;
    const int aoff = lds_byte(wr * 64 + fr, fq * 8), boff = lds_byte(wc * 32 + fr, fq * 8);
#define PG8_SA(b, h) (((b) * 2 + (h)) * HTB)
#define PG8_SB(b, h) ((4 + (b) * 2 + (h)) * HTB)
#define PG8_STAGEB(bufoff, gbase) do { _Pragma("unroll") for (int _i = 0; _i < 2; ++_i) \
        __builtin_amdgcn_global_load_lds((const unsigned*)((const char*)(gbase) + voffB[_i]), (LAS unsigned*)(lds + (bufoff) + ldsw + _i * 8192), 16, 0, 0); } while (0)
#define PG8_STAGEA(bufoff, gbase, h) do { _Pragma("unroll") for (int _i = 0; _i < 2; ++_i) \
        __builtin_amdgcn_global_load_lds((const unsigned*)((const char*)(gbase) + voffA[h][_i]), (LAS unsigned*)(lds + (bufoff) + ldsw + _i * 8192), 16, 0, 0); } while (0)
#define PG8_LDA(dst, b, h) do { _Pragma("unroll") for (int m = 0; m < 4; ++m) _Pragma("unroll") for (int k = 0; k < 2; ++k) dst[m][k] = *(const LAS bf16x8*)(lds + PG8_SA(b, h) + aoff + m * 2048 + k * 1024); } while (0)
#define PG8_LDB(dst, b, h) do { _Pragma("unroll") for (int n = 0; n < 2; ++n) _Pragma("unroll") for (int k = 0; k < 2; ++k) dst[n][k] = *(const LAS bf16x8*)(lds + PG8_SB(b, h) + boff + n * 2048 + k * 1024); } while (0)
#define PG8_MMA(ai, bj, At, Bt) do { __builtin_amdgcn_s_setprio(1); _Pragma("unroll") for (int m = 0; m < 4; ++m) _Pragma("unroll") for (int n = 0; n < 2; ++n) _Pragma("unroll") for (int k = 0; k < 2; ++k) \
        acc[ai][bj][m][n] = __builtin_amdgcn_mfma_f32_16x16x32_bf16(Bt[n][k], At[m][k], acc[ai][bj][m][n], 0, 0, 0); __builtin_amdgcn_s_setprio(0); } while (0)
#define PG8_WAIT_V(n) asm volatile("s_waitcnt vmcnt(" #n ")" ::: "memory")
#define PG8_WAIT_L(n) asm volatile("s_waitcnt lgkmcnt(" #n ")" ::: "memory")
#define PG8_BAR __builtin_amdgcn_s_barrier()
#define PG8_SCHED __builtin_amdgcn_sched_barrier(0)
#define PG8_GATHER_OFFS(uidx) do { if constexpr (GATHER) { _Pragma("unroll") for (int _i = 0; _i < 2; ++_i) { int R, C; stage_rc(tid * 16 + _i * 8192, R, C); \
        voffA[0][_i] = (unsigned)(rowtab[2 * ((uidx) * 256 + R)] * lda + C) * 2u; voffA[1][_i] = (unsigned)(rowtab[2 * ((uidx) * 256 + R + HALF)] * lda + C) * 2u; } } } while (0)
    Unit cur, nxt; int ui = 0;
    if (!S.next(0, cur)) return;
    f32x4 acc[2][2][4][2];
#pragma unroll
    for (int a = 0; a < 2; ++a)
#pragma unroll
        for (int b = 0; b < 2; ++b)
#pragma unroll
            for (int m = 0; m < 4; ++m)
#pragma unroll
                for (int n = 0; n < 2; ++n) acc[a][b][m][n] = (f32x4){0.f, 0.f, 0.f, 0.f};
    bf16x8 At[4][2], B0[2][2], B1[2][2];
    const char* cA = cur.a; const char* cB = cur.b;
    PG8_GATHER_OFFS(0);
    PG8_STAGEB(PG8_SB(0, 0), cB); PG8_STAGEB(PG8_SB(0, 1), cB + hstepB); PG8_STAGEA(PG8_SA(0, 0), cA, 0); PG8_STAGEA(PG8_SA(0, 1), cA, 1);
    if (wr == 1) PG8_BAR;
    PG8_WAIT_V(2); PG8_BAR;
    PG8_STAGEB(PG8_SB(1, 0), cB + kstep); PG8_STAGEA(PG8_SA(1, 0), cA + kstep, 0); PG8_STAGEB(PG8_SB(1, 1), cB + hstepB + kstep);
    PG8_WAIT_V(6); PG8_BAR;
    for (;;) {
        const bool has_next = S.next(ui + 1, nxt);
        const bool skip1 = GATHER_OR_RAGGED && (cur.nrows <= HALF);
        const char* nA = has_next ? nxt.a : cA; const char* nB = has_next ? nxt.b : cB;
        for (int t = 0; t < nt; t += 2) {
            const bool last = (t == nt - 2);
            const char* a1 = cA + (size_t)(t + 1) * kstep;
            const char* a2 = last ? nA : cA + (size_t)(t + 2) * kstep; const char* b2 = last ? nB : cB + (size_t)(t + 2) * kstep;
            const char* a3 = a2 + kstep; const char* b3 = b2 + kstep;
            PG8_LDB(B0, 0, 0); PG8_LDB(B1, 0, 1); PG8_SCHED; PG8_LDA(At, 0, 0); PG8_STAGEA(PG8_SA(1, 1), a1, 1);
            if (GATHER && last && has_next) PG8_GATHER_OFFS(ui + 1);
            PG8_WAIT_V(8); PG8_WAIT_L(0); PG8_BAR; PG8_MMA(0, 0, At, B0); PG8_MMA(0, 1, At, B1); PG8_BAR; PG8_SCHED;
            PG8_LDA(At, 0, 1); PG8_STAGEB(PG8_SB(0, 0), b2); PG8_STAGEB(PG8_SB(0, 1), b2 + hstepB); PG8_STAGEA(PG8_SA(0, 0), a2, 0);
            PG8_WAIT_V(8); PG8_WAIT_L(0); PG8_BAR; if (!skip1) { PG8_MMA(1, 0, At, B0); PG8_MMA(1, 1, At, B1); } PG8_BAR; PG8_SCHED;
            PG8_LDB(B0, 1, 0); PG8_LDB(B1, 1, 1); PG8_SCHED; PG8_LDA(At, 1, 0); PG8_STAGEA(PG8_SA(0, 1), a2, 1);
            PG8_WAIT_V(8); PG8_WAIT_L(0); PG8_BAR; PG8_MMA(0, 0, At, B0); PG8_MMA(0, 1, At, B1); PG8_BAR; PG8_SCHED;
            PG8_LDA(At, 1, 1); PG8_STAGEB(PG8_SB(1, 0), b3); PG8_STAGEB(PG8_SB(1, 1), b3 + hstepB); PG8_STAGEA(PG8_SA(1, 0), a3, 0);
            PG8_WAIT_V(8); PG8_WAIT_L(0); PG8_BAR; if (!skip1) { PG8_MMA(1, 0, At, B0); PG8_MMA(1, 1, At, B1); } PG8_BAR; PG8_SCHED;
        }
        if (wr == 0) PG8_BAR;
        E(acc, cur, ui, wr, wc, fr, fq);
        if (!has_next) break;
        if (!(CARRY_ACC && cur.aux == 1)) {
#pragma unroll
        for (int a = 0; a < 2; ++a)
#pragma unroll
            for (int b = 0; b < 2; ++b)
#pragma unroll
                for (int m = 0; m < 4; ++m)
#pragma unroll
                    for (int n = 0; n < 2; ++n) acc[a][b][m][n] = (f32x4){0.f, 0.f, 0.f, 0.f};
        }
        cur = nxt; cA = nA; cB = nB; ++ui;
        if (wr == 1) PG8_BAR;
    }
    PG8_WAIT_V(0);
    PG8_BAR;
#undef PG8_SA
#undef PG8_SB
#undef PG8_STAGEA
#undef PG8_STAGEB
#undef PG8_LDA
#undef PG8_LDB
#undef PG8_MMA
#undef PG8_WAIT_V
#undef PG8_WAIT_L
#undef PG8_BAR
#undef PG8_SCHED
#undef PG8_GATHER_OFFS
}

__device__ __forceinline__ float sigm(float x) { return __builtin_amdgcn_rcpf(1.f + __builtin_amdgcn_exp2f(-1.4426950408889634f * x)); }
__device__ __forceinline__ f32x4 bflo4(unsigned a, unsigned b) { return (f32x4){__uint_as_float(a << 16), __uint_as_float(a & 0xffff0000u), __uint_as_float(b << 16), __uint_as_float(b & 0xffff0000u)}; }
#define EPI_LOOP_AM _Pragma("unroll") for (int ai = 0; ai < 2; ++ai) _Pragma("unroll") for (int m = 0; m < 4; ++m)
#define EPI_LOOP_AM_H(u) _Pragma("unroll") for (int ai = 0; ai < 2; ++ai) if (ai * HALF < (u).nrows) _Pragma("unroll") for (int m = 0; m < 4; ++m)

struct EpiProj {
    static constexpr bool PERM = true;
    bf16* qkvu; bf16* gates; const float* bgate;
    __device__ __forceinline__ void operator()(const f32x4 (&acc)[2][2][4][2], const Unit& u, int, int wr, int wc, int fr, int fq) const {
        const int row0 = u.row0 + wr * 64 + fr;
        if (u.col0 < QKVU_LD) {
            const int col0 = u.col0 + wc * 32 + 8 * fq;
            EPI_LOOP_AM_H(u) { bf16* rowp = qkvu + (size_t)(row0 + ai * HALF + m * 16) * QKVU_LD + col0;
#pragma unroll
                for (int bj = 0; bj < 2; ++bj) { const f32x4 v0 = acc[ai][bj][m][0], v1 = acc[ai][bj][m][1];
                    u32x4 w; w.x = cvt_pk_bf16(v0[0], v0[1]); w.y = cvt_pk_bf16(v0[2], v0[3]); w.z = cvt_pk_bf16(v1[0], v1[1]); w.w = cvt_pk_bf16(v1[2], v1[3]);
                    *(u32x4*)(rowp + bj * HALF) = w; } }
        } else {
            const int col0 = u.col0 - QKVU_LD + wc * 32 + 8 * fq;
            f32x4 bv[2][2];
#pragma unroll
            for (int bj = 0; bj < 2; ++bj)
#pragma unroll
                for (int n = 0; n < 2; ++n) bv[bj][n] = *(const f32x4*)(bgate + col0 + bj * HALF + 4 * n);
            EPI_LOOP_AM_H(u) { bf16* rowp = gates + (size_t)(row0 + ai * HALF + m * 16) * GATEC + col0;
#pragma unroll
                for (int bj = 0; bj < 2; ++bj) { const f32x4 v0 = acc[ai][bj][m][0] + bv[bj][0], v1 = acc[ai][bj][m][1] + bv[bj][1];
                    u32x4 w; w.x = cvt_pk_bf16(sigm(v0[0]), sigm(v0[1])); w.y = cvt_pk_bf16(sigm(v0[2]), sigm(v0[3])); w.z = cvt_pk_bf16(sigm(v1[0]), sigm(v1[1])); w.w = cvt_pk_bf16(sigm(v1[2]), sigm(v1[3]));
                    *(u32x4*)(rowp + bj * HALF) = w; } }
        }
    }
};
struct EpiGlu {
    static constexpr bool PERM = true;
    const bf16* z; bf16* zg; const float* bglu;
    __device__ __forceinline__ void operator()(const f32x4 (&acc)[2][2][4][2], const Unit& u, int, int wr, int wc, int fr, int fq) const {
        const int row0 = u.row0 + wr * 64 + fr, col0 = u.col0 + wc * 32 + 8 * fq;
        f32x4 bv[2][2];
#pragma unroll
        for (int bj = 0; bj < 2; ++bj)
#pragma unroll
            for (int n = 0; n < 2; ++n) bv[bj][n] = *(const f32x4*)(bglu + col0 + bj * HALF + 4 * n);
        EPI_LOOP_AM_H(u) { const size_t off = (size_t)(row0 + ai * HALF + m * 16) * DSSM + col0;
#pragma unroll
            for (int bj = 0; bj < 2; ++bj) { const u32x4 zz = *(const u32x4*)(z + off + bj * HALF); const f32x4 z0 = bflo4(zz.x, zz.y), z1 = bflo4(zz.z, zz.w);
                const f32x4 v0 = acc[ai][bj][m][0] + bv[bj][0], v1 = acc[ai][bj][m][1] + bv[bj][1];
                u32x4 w; w.x = cvt_pk_bf16(z0[0] * sigm(v0[0]), z0[1] * sigm(v0[1])); w.y = cvt_pk_bf16(z0[2] * sigm(v0[2]), z0[3] * sigm(v0[3]));
                w.z = cvt_pk_bf16(z1[0] * sigm(v1[0]), z1[1] * sigm(v1[1])); w.w = cvt_pk_bf16(z1[2] * sigm(v1[2]), z1[3] * sigm(v1[3]));
                *(u32x4*)(zg + off + bj * HALF) = w; } }
    }
};
template <bool SECOND> struct EpiBranch {
    static constexpr bool PERM = true;
    const bf16* gates; bf16* pa; bf16* merged;
    __device__ __forceinline__ void operator()(const f32x4 (&acc)[2][2][4][2], const Unit& u, int, int wr, int wc, int fr, int fq) const {
        const int row0 = u.row0 + wr * 64 + fr, col0 = u.col0 + wc * 32 + 8 * fq;
        EPI_LOOP_AM { const int row = row0 + ai * HALF + m * 16; const size_t off = (size_t)row * D + col0; const size_t goff = (size_t)row * GATEC + (SECOND ? D : 0) + col0;
#pragma unroll
            for (int bj = 0; bj < 2; ++bj) { const u32x4 gg = *(const u32x4*)(gates + goff + bj * HALF); const f32x4 g0 = bflo4(gg.x, gg.y), g1 = bflo4(gg.z, gg.w);
                f32x4 v0 = acc[ai][bj][m][0] * g0, v1 = acc[ai][bj][m][1] * g1;
                if (SECOND) { const u32x4 pp = *(const u32x4*)(pa + off + bj * HALF); v0 += bflo4(pp.x, pp.y); v1 += bflo4(pp.z, pp.w); }
                u32x4 w; w.x = cvt_pk_bf16(v0[0], v0[1]); w.y = cvt_pk_bf16(v0[2], v0[3]); w.z = cvt_pk_bf16(v1[0], v1[1]); w.w = cvt_pk_bf16(v1[2], v1[3]);
                *(u32x4*)((SECOND ? merged : pa) + off + bj * HALF) = w; } }
    }
};

struct BranchSched {
    StaticOrder so; const char *A1, *B1, *A2, *B2;
    __device__ __forceinline__ bool next(int i, Unit& u) const {
        int pm, pn; if (!so.next(i >> 1, pm, pn)) return false;
        const size_t step = (size_t)256 * 512 * 2; const bool first = (i & 1) == 0;
        u.a = (first ? A1 : A2) + (size_t)pm * step; u.b = (first ? B1 : B2) + (size_t)pn * step; u.aux = first ? 1 : 0;
        u.row0 = pm * BM; u.col0 = pn * BM; u.nrows = BM; u.rt = 0; return true;
    }
};
struct EpiBranch2 {
    static constexpr bool PERM = true;
    const bf16* gates; bf16* merged;
    __device__ __forceinline__ void operator()(f32x4 (&acc)[2][2][4][2], const Unit& u, int, int wr, int wc, int fr, int fq) const {
        const int row0 = u.row0 + wr * 64 + fr, col0 = u.col0 + wc * 32 + 8 * fq;
        if (u.aux == 1) {
            EPI_LOOP_AM { const int row = row0 + ai * HALF + m * 16; const size_t goff = (size_t)row * GATEC + col0;
#pragma unroll
                for (int bj = 0; bj < 2; ++bj) { const u32x4 ga = *(const u32x4*)(gates + goff + bj * HALF), gs = *(const u32x4*)(gates + goff + D + bj * HALF);
                    const f32x4 a0 = bflo4(ga.x, ga.y), a1 = bflo4(ga.z, ga.w), s0 = bflo4(gs.x, gs.y), s1 = bflo4(gs.z, gs.w);
#pragma unroll
                    for (int j = 0; j < 4; ++j) { acc[ai][bj][m][0][j] *= a0[j] * __builtin_amdgcn_rcpf(fmaxf(s0[j], 1e-30f)); acc[ai][bj][m][1][j] *= a1[j] * __builtin_amdgcn_rcpf(fmaxf(s1[j], 1e-30f)); } } }
        } else {
            EPI_LOOP_AM { const int row = row0 + ai * HALF + m * 16; const size_t off = (size_t)row * D + col0; const size_t goff = (size_t)row * GATEC + D + col0;
#pragma unroll
                for (int bj = 0; bj < 2; ++bj) { const u32x4 gg = *(const u32x4*)(gates + goff + bj * HALF); const f32x4 v0 = acc[ai][bj][m][0] * bflo4(gg.x, gg.y), v1 = acc[ai][bj][m][1] * bflo4(gg.z, gg.w);
                    u32x4 w; w.x = cvt_pk_bf16(v0[0], v0[1]); w.y = cvt_pk_bf16(v0[2], v0[3]); w.z = cvt_pk_bf16(v1[0], v1[1]); w.w = cvt_pk_bf16(v1[2], v1[3]);
                    *(u32x4*)(merged + off + bj * HALF) = w; } }
        }
    }
};
struct EpiDelta {
    static constexpr bool PERM = true;
    bf16* delta;
    __device__ __forceinline__ void operator()(const f32x4 (&acc)[2][2][4][2], const Unit& u, int, int wr, int wc, int fr, int fq) const {
        const int row0 = u.row0 + wr * 64 + fr, col0 = u.col0 + wc * 32 + 8 * fq;
        EPI_LOOP_AM { bf16* rowp = delta + (size_t)(row0 + ai * HALF + m * 16) * D + col0;
#pragma unroll
            for (int bj = 0; bj < 2; ++bj) { const f32x4 v0 = acc[ai][bj][m][0], v1 = acc[ai][bj][m][1];
                u32x4 w; w.x = cvt_pk_bf16(v0[0], v0[1]); w.y = cvt_pk_bf16(v0[2], v0[3]); w.z = cvt_pk_bf16(v1[0], v1[1]); w.w = cvt_pk_bf16(v1[2], v1[3]);
                *(u32x4*)(rowp + bj * HALF) = w; } }
    }
};
struct EpiOut {
    static constexpr bool PERM = false;
    const float* x; float* x1;
    __device__ __forceinline__ void operator()(const f32x4 (&acc)[2][2][4][2], const Unit& u, int, int wr, int wc, int fr, int fq) const {
        const int row0 = u.row0 + wr * 64 + fr, col0 = u.col0 + wc * 32 + 4 * fq;
        EPI_LOOP_AM { const size_t off = (size_t)(row0 + ai * HALF + m * 16) * D + col0;
#pragma unroll
            for (int bj = 0; bj < 2; ++bj)
#pragma unroll
                for (int n = 0; n < 2; ++n) { const f32x4 xv = *(const f32x4*)(x + off + bj * HALF + n * 16); *(f32x4*)(x1 + off + bj * HALF + n * 16) = xv + acc[ai][bj][m][n]; } }
    }
};

struct MoeSched {
    const LAS int* tpre; const LAS int* rbase;
    int U, G, c; const char* A; const char* B; size_t bstepE, bstepN, arow; bool gather;
    __device__ __forceinline__ bool next(int i, Unit& u) const {
        int L = i * G + c;
        if (G == 256) { const int xcd = c & 7, slot = c >> 3; L = 4 * (i * 64 + xcd * 8 + (slot >> 2)) + (slot & 3); }
        if (L >= U) return false;
        const int pn = L & 3; const int tile = tpre[L >> 2]; const int e = tile >> 8, rt = tile & 255;
        u.aux = e; u.rt = rt; u.row0 = rbase[e] + rt * BM; const int left = rbase[e + 1] - u.row0; u.nrows = left < BM ? left : BM; u.col0 = pn * BM;
        u.a = gather ? A : A + (size_t)u.row0 * arow; u.b = B + (size_t)e * bstepE + (size_t)pn * bstepN; return true;
    }
};
struct EpiAct {
    static constexpr bool PERM = true;
    bf16* act; const LAS int* rowtab;
    __device__ __forceinline__ void operator()(const f32x4 (&acc)[2][2][4][2], const Unit& u, int ui, int wr, int wc, int fr, int fq) const {
        const int acol = (u.col0 >> 1) + wc * 32 + 8 * fq;
        EPI_LOOP_AM { const int r = ai * HALF + wr * 64 + m * 16 + fr;
            if (r < u.nrows) { const float inv = __int_as_float(rowtab[2 * (ui * 256 + r) + 1]);
                float o[8];
#pragma unroll
                for (int n = 0; n < 2; ++n)
#pragma unroll
                    for (int j = 0; j < 4; ++j) { const float g = acc[ai][0][m][n][j] * inv, uu = acc[ai][1][m][n][j] * inv; o[4 * n + j] = g * sigm(g) * uu; }
                u32x4 w; w.x = cvt_pk_bf16(o[0], o[1]); w.y = cvt_pk_bf16(o[2], o[3]); w.z = cvt_pk_bf16(o[4], o[5]); w.w = cvt_pk_bf16(o[6], o[7]);
                *(u32x4*)(act + (size_t)(u.row0 + r) * DFF + acol) = w; } }
    }
};
struct EpiDown {
    static constexpr bool PERM = true;
    bf16* contrib; const LAS int* rowtab;
    __device__ __forceinline__ void operator()(const f32x4 (&acc)[2][2][4][2], const Unit& u, int ui, int wr, int wc, int fr, int fq) const {
        const int col0 = u.col0 + wc * 32 + 8 * fq;
        EPI_LOOP_AM { const int r = ai * HALF + wr * 64 + m * 16 + fr;
            if (r < u.nrows) { const int ent = rowtab[2 * (ui * 256 + r)]; const float wt = __int_as_float(rowtab[2 * (ui * 256 + r) + 1]);
                bf16* dst = contrib + ((size_t)(ent & 1) * M + (ent >> 1)) * D + col0;
#pragma unroll
                for (int bj = 0; bj < 2; ++bj) { const f32x4 v0 = acc[ai][bj][m][0] * wt, v1 = acc[ai][bj][m][1] * wt;
                    u32x4 w; w.x = cvt_pk_bf16(v0[0], v0[1]); w.y = cvt_pk_bf16(v0[2], v0[3]); w.z = cvt_pk_bf16(v1[0], v1[1]); w.w = cvt_pk_bf16(v1[2], v1[3]);
                    *(u32x4*)(dst + bj * HALF) = w; } } }
    }
};
}


__device__ __forceinline__ float gelu_fast(float x) {
    const float u = 0.7978845608028654f * (x + 0.044715f * x * x * x);
    const float e = __builtin_amdgcn_exp2f(2.885390081777927f * u);
    return 0.5f * x * (2.f - 2.f * __builtin_amdgcn_rcpf(e + 1.f));
}

namespace s5 {
typedef short bf16x8 __attribute__((ext_vector_type(8)));
typedef float f32x16 __attribute__((ext_vector_type(16)));
typedef unsigned u32x2 __attribute__((ext_vector_type(2)));
constexpr int ROWB = 272;
constexpr int WAVE_LDS = 32 * ROWB;
template <bool PHASE_C>
__device__ __forceinline__ void run(int un, const bf16* qkvu, const u32x4* bbt, const u32x4* cmt, const float2* lamb, const float2* lamL, float2* sse, const float* dsk, bf16* zbuf, LAS unsigned char* lds) {
    const int tid = threadIdx.x, lane = tid & 63, w = __builtin_amdgcn_readfirstlane(tid >> 6), j = lane & 31, h = lane >> 5;
    const int b = un >> 7, pair = (un & 127) >> 2, g = (un & 3) * 8 + w;
    const int ksub = 2 * pair + h;
    const float2 lam0 = lamb[g * PS + j], lam1 = lamb[g * PS + 32 + j];
    bf16x8 bfrag[4];
#pragma unroll
    for (int t = 0; t < 4; ++t) bfrag[t] = __builtin_bit_cast(bf16x8, bbt[(g * 4 + t) * 64 + lane]);
    const int r = lane & 31, sA = (r >> 2) & 1, tokA = 4 * (r >> 3) + (r & 3);
    const bf16* up = qkvu + ((size_t)b * SEQ + (size_t)(2 * pair + sA) * LSUB + tokA) * QKVU_LD + UOFF + g * GC + 8 * h;
    u32x4 afr[8];
#pragma unroll
    for (int st = 0; st < 8; ++st) afr[st] = *(const u32x4*)(up + (size_t)st * 16 * QKVU_LD);
    float s0r = 0.f, s0i = 0.f, s1r = 0.f, s1i = 0.f;
    if (PHASE_C) {
        const float2 L0 = lamL[g * PS + j], L1 = lamL[g * PS + 32 + j];
        const float2* e0 = sse + ((size_t)b * NSUB * NG + g) * PS + j;
        const int kmax = 2 * pair + 1;
#pragma unroll 1
        for (int m0 = 0; m0 < kmax; m0 += 16) {
            float2 ea[16], eb[16];
#pragma unroll
            for (int q = 0; q < 16; ++q) { const int m = m0 + q; const int mm = (m < ksub) ? m : 0;
                ea[q] = e0[(size_t)mm * NG * PS]; eb[q] = e0[(size_t)mm * NG * PS + 32]; }
#pragma unroll
            for (int q = 0; q < 16; ++q) { const bool ok = (m0 + q) < ksub;
                const float n0r = opq(opq(L0.x * s0r + ea[q].x) - L0.y * s0i), n0i = opq(opq(L0.x * s0i + ea[q].y) + L0.y * s0r);
                const float n1r = opq(opq(L1.x * s1r + eb[q].x) - L1.y * s1i), n1i = opq(opq(L1.x * s1i + eb[q].y) + L1.y * s1r);
                s0r = ok ? n0r : s0r; s0i = ok ? n0i : s0i; s1r = ok ? n1r : s1r; s1i = ok ? n1i : s1i; }
        }
    }
    bf16x8 cfr[4]; f32x4 dsk4 = {0.f, 0.f, 0.f, 0.f};
    if (PHASE_C) {
#pragma unroll
        for (int ks = 0; ks < 4; ++ks) cfr[ks] = __builtin_bit_cast(bf16x8, cmt[(g * 4 + ks) * 64 + lane]);
        dsk4 = *(const f32x4*)(dsk + g * GC + 4 * (lane >> 4));
    }
    LAS unsigned char* wl = lds + w * WAVE_LDS;
    const f32x16 zero16 = {0.f, 0.f, 0.f, 0.f, 0.f, 0.f, 0.f, 0.f, 0.f, 0.f, 0.f, 0.f, 0.f, 0.f, 0.f, 0.f};
#pragma unroll 1
    for (int st = 0; st < 8; ++st) {
        u32x4 av = afr[0];
#pragma unroll
        for (int q = 1; q < 8; ++q) av = (st == q) ? afr[q] : av;
        const bf16x8 a = __builtin_bit_cast(bf16x8, av);
        f32x16 t0 = __builtin_amdgcn_mfma_f32_32x32x16_bf16(a, bfrag[0], zero16, 0, 0, 0);
        mfma_keep(a, bfrag[0], t0[0]);
        f32x16 t1 = __builtin_amdgcn_mfma_f32_32x32x16_bf16(a, bfrag[1], zero16, 0, 0, 0);
        mfma_keep(a, bfrag[1], t1[0]);
        f32x16 t2 = __builtin_amdgcn_mfma_f32_32x32x16_bf16(a, bfrag[2], zero16, 0, 0, 0);
        mfma_keep(a, bfrag[2], t2[0]);
        f32x16 t3 = __builtin_amdgcn_mfma_f32_32x32x16_bf16(a, bfrag[3], zero16, 0, 0, 0);
        mfma_keep(a, bfrag[3], t3[0]);
#pragma unroll
        for (int i = 0; i < 16; ++i) {
            const float n0r = opq(opq(lam0.x * s0r + t0[i]) - lam0.y * s0i), n0i = opq(opq(lam0.x * s0i + t1[i]) + lam0.y * s0r); s0r = n0r; s0i = n0i;
            const float n1r = opq(opq(lam1.x * s1r + t2[i]) - lam1.y * s1i), n1i = opq(opq(lam1.x * s1i + t3[i]) + lam1.y * s1r); s1r = n1r; s1i = n1i;
            if (PHASE_C) { u32x2 pk; pk.x = pg8::cvt_pk_bf16(s0r, s0i); pk.y = pg8::cvt_pk_bf16(s1r, s1i);
                *(LAS u32x2*)(wl + (h * 16 + i) * ROWB + 8 * j) = pk; }
        }
        if (PHASE_C) {
            asm volatile("" ::: "memory");
#pragma unroll
            for (int nt = 0; nt < 2; ++nt) {
                f32x4 y = {0.f, 0.f, 0.f, 0.f};
#pragma unroll
                for (int ks = 0; ks < 4; ++ks) { const bf16x8 sb = __builtin_bit_cast(bf16x8, *(const LAS u32x4*)(wl + (nt * 16 + (lane & 15)) * ROWB + (ks * 32 + 8 * (lane >> 4)) * 2));
                    y = __builtin_amdgcn_mfma_f32_16x16x32_bf16(cfr[ks], sb, y, 0, 0, 0); mfma_keep(cfr[ks], sb, y[0]); }
                const size_t row = (size_t)b * SEQ + (size_t)(2 * pair + nt) * LSUB + st * 16 + (lane & 15);
                const u32x2 uu = *(const u32x2*)(qkvu + row * QKVU_LD + UOFF + g * GC + 4 * (lane >> 4));
                const f32x4 uf = pg8::bflo4(uu.x, uu.y);
                const f32x4 v = y + dsk4 * uf;
                u32x2 o; o.x = pg8::cvt_pk_bf16(gelu_fast(v[0]), gelu_fast(v[1])); o.y = pg8::cvt_pk_bf16(gelu_fast(v[2]), gelu_fast(v[3]));
                *(u32x2*)(zbuf + row * DSSM + g * GC + 4 * (lane >> 4)) = o;
            }
            asm volatile("" ::: "memory");
        }
    }
    if (!PHASE_C) { float2* e = sse + (((size_t)b * NSUB + ksub) * NG + g) * PS; e[j] = make_float2(s0r, s0i); e[32 + j] = make_float2(s1r, s1i); }
}
}

__device__ __forceinline__ unsigned pk2(float lo, float hi) { return (unsigned)f2bf(lo) | ((unsigned)f2bf(hi) << 16); }
struct CvDesc { const float* W; bf16* dst; const float* ksc; int N, K; };
__device__ __forceinline__ void cv_load(const CvDesc& d, int lane, f32x4 (&tv)[8]) {
    const float* p = d.W + (size_t)(lane >> 3) * d.N + 4 * (lane & 7);
#pragma unroll
    for (int i = 0; i < 8; ++i) tv[i] = __builtin_nontemporal_load((const f32x4*)(p + (size_t)(8 * i) * d.N));
}
__device__ __forceinline__ void cv_finish(const CvDesc& d, int lane, const f32x4 (&tv)[8], LAS float* scr) {
#pragma unroll
    for (int i = 0; i < 8; ++i) { LAS float* w = scr + ((lane >> 3) + 8 * i) * 33 + 4 * (lane & 7); w[0] = tv[i][0]; w[1] = tv[i][1]; w[2] = tv[i][2]; w[3] = tv[i][3]; }
    asm volatile("s_waitcnt lgkmcnt(0)" ::: "memory");
    const int c = lane & 7;
    f32x4 g0 = {1.f, 1.f, 1.f, 1.f}, g1 = g0;
    if (d.ksc) { g0 = *(const f32x4*)(d.ksc + 8 * c); g1 = *(const f32x4*)(d.ksc + 8 * c + 4); }
#pragma unroll
    for (int jj = 0; jj < 4; ++jj) { const int n = (lane >> 3) + 8 * jj; const LAS float* sp = scr + (8 * c) * 33 + n;
        u32x4 o; o.x = pk2(sp[0 * 33] * g0[0], sp[1 * 33] * g0[1]); o.y = pk2(sp[2 * 33] * g0[2], sp[3 * 33] * g0[3]); o.z = pk2(sp[4 * 33] * g1[0], sp[5 * 33] * g1[1]); o.w = pk2(sp[6 * 33] * g1[2], sp[7 * 33] * g1[3]);
        *(u32x4*)(d.dst + (size_t)n * d.K + 8 * c) = o; }
    asm volatile("s_waitcnt lgkmcnt(0)" ::: "memory");
}

namespace att {
typedef short bf16x8 __attribute__((ext_vector_type(8)));
typedef float f32x16 __attribute__((ext_vector_type(16)));
typedef unsigned u32x2 __attribute__((ext_vector_type(2)));
constexpr int KP = 144, VP = 520, V_OFF = 256 * KP;
__device__ __forceinline__ void load_kv(int un, const bf16* qkvu, u32x4 (&kvreg)[8]) {
    const int tid = threadIdx.x, b = un >> 7, nb = (un >> 1) & 63, kvh = un & 1, blk = nb * 128; const size_t rowbase = (size_t)b * SEQ;
#pragma unroll
    for (int cc = 0; cc < 4; ++cc) { const int c = tid + 512 * cc, key = c >> 3, dc = c & 7; int kp = blk - 128 + key; kp = kp < 0 ? 0 : kp;
        const bf16* src = qkvu + (rowbase + kp) * QKVU_LD + kvh * HD + dc * 8;
        kvreg[2 * cc] = *(const u32x4*)(src + KOFF); kvreg[2 * cc + 1] = *(const u32x4*)(src + VOFF); }
}
__device__ __forceinline__ void unit(int un, const bf16* qkvu, const float* sinks, bf16* attn, LAS unsigned char* lds, const u32x4 (&kvreg)[8]) {
    const int tid = threadIdx.x, lane = tid & 63, w = __builtin_amdgcn_readfirstlane(tid >> 6), l31 = lane & 31, h = lane >> 5;
    const int b = un >> 7, nb = (un >> 1) & 63, kvh = un & 1, blk = nb * 128; const size_t rowbase = (size_t)b * SEQ;
    __syncthreads();
#pragma unroll
    for (int cc = 0; cc < 4; ++cc) { const int c = tid + 512 * cc, key = c >> 3, dc = c & 7;
        const u32x4 kv = kvreg[2 * cc], vv = kvreg[2 * cc + 1];
        *(LAS u32x4*)(lds + key * KP + dc * 16) = kv;
#pragma unroll
        for (int i = 0; i < 4; ++i) { *(LAS bf16*)(lds + V_OFF + (dc * 8 + 2 * i) * VP + key * 2) = (bf16)(vv[i] & 0xffffu); *(LAS bf16*)(lds + V_OFF + (dc * 8 + 2 * i + 1) * VP + key * 2) = (bf16)(vv[i] >> 16); } }
    __syncthreads();
    const int hq = kvh * 4 + (w >> 1), qh = w & 1;
    const float sink2 = sinks[hq] * 1.4426950408889634f;
    const float c1 = 0.125f * 1.4426950408889634f;
    const f32x16 zero16 = {0.f, 0.f, 0.f, 0.f, 0.f, 0.f, 0.f, 0.f, 0.f, 0.f, 0.f, 0.f, 0.f, 0.f, 0.f, 0.f};
#pragma unroll 1
    for (int qt = 0; qt < 2; ++qt) {
        const int q0 = qh * 64 + qt * 32, kt0 = q0 >> 5, iq = q0 + l31;
        const size_t qrow = rowbase + blk + iq;
        bf16x8 qf[4];
#pragma unroll
        for (int s = 0; s < 4; ++s) qf[s] = __builtin_bit_cast(bf16x8, *(const u32x4*)(qkvu + qrow * QKVU_LD + QOFF + hq * HD + 16 * s + 8 * h));
        f32x16 sc[5];
#pragma unroll
        for (int t = 0; t < 5; ++t) { f32x16 acc = zero16;
#pragma unroll
            for (int s = 0; s < 4; ++s) { const bf16x8 kf = *(const LAS bf16x8*)(lds + ((kt0 + t) * 32 + l31) * KP + (16 * s + 8 * h) * 2); acc = __builtin_amdgcn_mfma_f32_32x32x16_bf16(kf, qf[s], acc, 0, 0, 0); mfma_keep(kf, qf[s], acc[0]); }
            sc[t] = acc; }
        float mx = sink2;
#pragma unroll
        for (int t = 0; t < 5; ++t)
#pragma unroll
            for (int i = 0; i < 16; ++i) { const int jk = (kt0 + t) * 32 + (i & 3) + 8 * (i >> 2) + 4 * h; const int rel = jk - iq; const bool ok = (rel >= 1) && (rel <= 128) && (blk - 128 + jk >= 0);
                const float v = ok ? sc[t][i] * c1 : -INFINITY; sc[t][i] = v; mx = fmaxf(mx, v); }
        mx = fmaxf(mx, __shfl_xor(mx, 32));
        float sum = 0.f;
#pragma unroll
        for (int t = 0; t < 5; ++t)
#pragma unroll
            for (int i = 0; i < 16; ++i) { const float p = __builtin_amdgcn_exp2f(sc[t][i] - mx); sc[t][i] = p; sum += p; }
        sum += __shfl_xor(sum, 32);
        const float rinv = 1.f / (sum + __builtin_amdgcn_exp2f(sink2 - mx));
        f32x16 o0 = zero16, o1 = zero16;
#pragma unroll
        for (int t = 0; t < 5; ++t)
#pragma unroll
            for (int s = 0; s < 2; ++s) {
                u32x4 pw; pw.x = pg8::cvt_pk_bf16(sc[t][8 * s + 0], sc[t][8 * s + 1]); pw.y = pg8::cvt_pk_bf16(sc[t][8 * s + 2], sc[t][8 * s + 3]); pw.z = pg8::cvt_pk_bf16(sc[t][8 * s + 4], sc[t][8 * s + 5]); pw.w = pg8::cvt_pk_bf16(sc[t][8 * s + 6], sc[t][8 * s + 7]);
                const bf16x8 pb = __builtin_bit_cast(bf16x8, pw);
                const int kofs = ((kt0 + t) * 32 + 16 * s + 4 * h) * 2;
                { const u32x2 a = *(const LAS u32x2*)(lds + V_OFF + l31 * VP + kofs), c = *(const LAS u32x2*)(lds + V_OFF + l31 * VP + kofs + 16); u32x4 vw; vw.x = a.x; vw.y = a.y; vw.z = c.x; vw.w = c.y;
                  const bf16x8 va = __builtin_bit_cast(bf16x8, vw); o0 = __builtin_amdgcn_mfma_f32_32x32x16_bf16(va, pb, o0, 0, 0, 0); mfma_keep(va, pb, o0[0]); }
                { const u32x2 a = *(const LAS u32x2*)(lds + V_OFF + (32 + l31) * VP + kofs), c = *(const LAS u32x2*)(lds + V_OFF + (32 + l31) * VP + kofs + 16); u32x4 vw; vw.x = a.x; vw.y = a.y; vw.z = c.x; vw.w = c.y;
                  const bf16x8 va = __builtin_bit_cast(bf16x8, vw); o1 = __builtin_amdgcn_mfma_f32_32x32x16_bf16(va, pb, o1, 0, 0, 0); mfma_keep(va, pb, o1[0]); }
            }
        bf16* orow = attn + qrow * DATT + hq * HD + 4 * h;
#pragma unroll
        for (int a = 0; a < 4; ++a) { u32x2 w0, w1; w0.x = pg8::cvt_pk_bf16(o0[4 * a] * rinv, o0[4 * a + 1] * rinv); w0.y = pg8::cvt_pk_bf16(o0[4 * a + 2] * rinv, o0[4 * a + 3] * rinv);
            w1.x = pg8::cvt_pk_bf16(o1[4 * a] * rinv, o1[4 * a + 1] * rinv); w1.y = pg8::cvt_pk_bf16(o1[4 * a + 2] * rinv, o1[4 * a + 3] * rinv);
            *(u32x2*)(orow + 8 * a) = w0; *(u32x2*)(orow + 32 + 8 * a) = w1; }
    }
}
}

#define XB_TMO      128
#define XB_XCNT(j)  (256  + 64 * (j))
#define XB_XSUB(j)  (1280 + 64 * (j))
#define XB_XGEN(j)  (2304 + 64 * (j))
#define XB_TOP      3328
#define XB_TOPGEN   3392
#define XCD_BAR_WORDS 3456
#ifndef XB_SPIN_CAP
#define XB_SPIN_CAP (1u << 24)
#endif
__device__ __forceinline__ unsigned xb_ld(unsigned* p)              { return __hip_atomic_load(p, __ATOMIC_RELAXED, __HIP_MEMORY_SCOPE_AGENT); }
__device__ __forceinline__ unsigned xb_add(unsigned* p, unsigned v) { return __hip_atomic_fetch_add(p, v, __ATOMIC_RELAXED, __HIP_MEMORY_SCOPE_AGENT); }
__device__ __forceinline__ unsigned xb_xcc_id() { return (unsigned)__builtin_amdgcn_s_getreg((3 << 11) | 20) & 0xFu; }
#define XB_SPIN(cond, bar) do { unsigned _sp = 0; while (cond) { __builtin_amdgcn_s_sleep(1); \
    if ((++_sp & 255u) == 0u) { if (xb_ld(&(bar)[XB_TMO])) break; if (_sp > XB_SPIN_CAP) { atomicAdd(&(bar)[XB_TMO], 1u); break; } } } } while (0)
struct XcdBarrier { unsigned* bar; unsigned x; volatile LAS unsigned* st; };
__device__ __forceinline__ XcdBarrier xcd_barrier_post(unsigned* bar, volatile LAS unsigned* st) {
    XcdBarrier b; b.bar = bar; b.x = xb_xcc_id(); b.st = st;
    if (threadIdx.x == 0) (void)xb_add(&bar[XB_XCNT(b.x)], 1u);
    return b;
}
__device__ __forceinline__ void xcd_barrier_complete(unsigned* bar, unsigned x, unsigned& nloc, unsigned& nx) {
    const unsigned G = gridDim.x * gridDim.y * gridDim.z;
    unsigned sum, cnt, mine, sp = 0u;
    for (;;) {
        sum = 0u; cnt = 0u; mine = 0u;
#pragma unroll
        for (unsigned j = 0; j < 16; ++j) { const unsigned c = xb_ld(&bar[XB_XCNT(j)]); sum += c; cnt += (c > 0u) ? 1u : 0u; mine = (j == x) ? c : mine; }
        if (sum == G) break;
        __builtin_amdgcn_s_sleep(1);
        if ((++sp & 255u) == 0u) { if (xb_ld(&bar[XB_TMO])) break; if (sp > XB_SPIN_CAP) { atomicAdd(&bar[XB_TMO], 1u); break; } }
    }
    nloc = mine > 0u ? mine : 1u; nx = cnt > 0u ? cnt : 1u;
}
__device__ __forceinline__ void xcd_barrier(const XcdBarrier& b) {
    asm volatile("s_waitcnt vmcnt(0)" ::: "memory");
    __syncthreads();
    if (threadIdx.x == 0) {
        unsigned* bar = b.bar;
        __builtin_amdgcn_s_waitcnt(0);
        unsigned nloc = b.st[0], nx = b.st[1];
        if (nloc == 0u) { xcd_barrier_complete(bar, b.x, nloc, nx); b.st[0] = nloc; b.st[1] = nx; }
        const unsigned old = xb_add(&bar[XB_XSUB(b.x)], 1u);
        const unsigned gen = old / nloc;
        if (old + 1u == (gen + 1u) * nloc) {
            __builtin_amdgcn_fence(__ATOMIC_RELEASE, "agent");
            asm volatile("s_waitcnt vmcnt(0)" ::: "memory");
            const unsigned og = xb_add(&bar[XB_TOP], 1u);
            const unsigned tg = og / nx;
            if (og + 1u == (tg + 1u) * nx) xb_add(&bar[XB_TOPGEN], 1u);
            else XB_SPIN(xb_ld(&bar[XB_TOPGEN]) == tg, bar);
            __builtin_amdgcn_fence(__ATOMIC_ACQUIRE, "agent");
            xb_add(&bar[XB_XGEN(b.x)], 1u);
            asm volatile("s_waitcnt vmcnt(0)" ::: "memory");
        } else {
            XB_SPIN(xb_ld(&bar[XB_XGEN(b.x)]) == gen, bar);
            __builtin_amdgcn_fence(__ATOMIC_ACQUIRE, "agent");
            asm volatile("s_waitcnt vmcnt(0)" ::: "memory");
        }
    }
    __syncthreads();
}

struct XbTicket { unsigned mode, val; };
__device__ __forceinline__ XbTicket xcd_barrier_arrive(const XcdBarrier& b) {
    XbTicket t; t.mode = 0u; t.val = 0u;
    asm volatile("s_waitcnt vmcnt(0)" ::: "memory");
    __syncthreads();
    if (threadIdx.x == 0) {
        unsigned* bar = b.bar;
        __builtin_amdgcn_s_waitcnt(0);
        unsigned nloc = b.st[0], nx = b.st[1];
        if (nloc == 0u) { xcd_barrier_complete(bar, b.x, nloc, nx); b.st[0] = nloc; b.st[1] = nx; }
        const unsigned old = xb_add(&bar[XB_XSUB(b.x)], 1u);
        const unsigned gen = old / nloc;
        if (old + 1u == (gen + 1u) * nloc) {
            __builtin_amdgcn_fence(__ATOMIC_RELEASE, "agent");
            asm volatile("s_waitcnt vmcnt(0)" ::: "memory");
            const unsigned og = xb_add(&bar[XB_TOP], 1u);
            const unsigned tg = og / nx;
            if (og + 1u == (tg + 1u) * nx) { xb_add(&bar[XB_TOPGEN], 1u); t.mode = 0u; }
            else { t.mode = 1u; t.val = tg; }
        } else { t.mode = 2u; t.val = gen; }
    }
    return t;
}
__device__ __forceinline__ void xcd_barrier_wait(const XcdBarrier& b, const XbTicket& t) {
    asm volatile("s_waitcnt vmcnt(0)" ::: "memory");
    __syncthreads();
    if (threadIdx.x == 0) {
        unsigned* bar = b.bar;
        if (t.mode <= 1u) {
            if (t.mode == 1u) XB_SPIN(xb_ld(&bar[XB_TOPGEN]) == t.val, bar);
            __builtin_amdgcn_fence(__ATOMIC_ACQUIRE, "agent");
            xb_add(&bar[XB_XGEN(b.x)], 1u);
            asm volatile("s_waitcnt vmcnt(0)" ::: "memory");
        } else {
            XB_SPIN(xb_ld(&bar[XB_XGEN(b.x)]) == t.val, bar);
            __builtin_amdgcn_fence(__ATOMIC_ACQUIRE, "agent");
            asm volatile("s_waitcnt vmcnt(0)" ::: "memory");
        }
    }
    __syncthreads();
}

struct Args { const float* in[27]; float* out; unsigned char* ws; int ph_lo, ph_hi; };

template <class F>
__device__ __forceinline__ void naive_gemm(const bf16* A, int lda, const bf16* Bt, int ldb, int Mr, int N, int K, F epi, long gt, long NT) {
    for (long idx = gt; idx < (long)Mr * N; idx += NT) {
        const int m = (int)(idx / N), n = (int)(idx % N);
        const u32x4* a = (const u32x4*)(A + (size_t)m * lda); const u32x4* b = (const u32x4*)(Bt + (size_t)n * ldb);
        float acc = 0.f;
#pragma unroll 4
        for (int k8 = 0; k8 < K / 8; ++k8) acc += dot8(a[k8], b[k8]);
        epi(m, n, acc);
    }
}

__global__ void __launch_bounds__(NTHREADS, 2) fwd(Args args) {
    extern __shared__ __attribute__((aligned(16))) unsigned char lds[];
#define PH_IDX const int tid = threadIdx.x, lane = tid & 63, wave = tid >> 6; const long gt = (long)blockIdx.x * NTHREADS + tid, NT = (long)gridDim.x * NTHREADS; \
    const int gw = blockIdx.x * NWAVES + wave, NW = gridDim.x * NWAVES; (void)lane; (void)gt; (void)NT; (void)gw; (void)NW;
    unsigned char* ws = args.ws;
    unsigned* ctl = (unsigned*)(ws + WS_CTL);
    const float* x = args.in[0];
    float* out = args.out;
    unsigned char* dout_b = (unsigned char*)args.out;
    bf16* WinT = (bf16*)(ws + WS_WIN); bf16* WgluT = (bf16*)(ws + WS_WGLU); bf16* WaT = (bf16*)(ws + WS_WA); bf16* WsT = (bf16*)(ws + WS_WS); bf16* WoutT = (bf16*)(ws + WS_WOUT);
    bf16* WguT = (bf16*)(ws + WS_WGU); bf16* WdT = (bf16*)(ws + WS_WD);
    bf16* hbuf = (bf16*)(ws + WS_R1); bf16* act = (bf16*)(ws + WS_R1); bf16* pabuf = (bf16*)(ws + WS_R1);
    LAS unsigned char* ldsp = (LAS unsigned char*)lds;
    bf16* gates = (bf16*)(ws + WS_GATES); bf16* delta = (bf16*)(ws + WS_GATES);
    bf16* contrib = (bf16*)(ws + WS_WGU);
    bf16* qkvu = (bf16*)(ws + WS_QKVU); bf16* merged = (bf16*)(ws + WS_QKVU); bf16* h2u = (bf16*)(ws + WS_QKVU);
    bf16* attn = (bf16*)(dout_b + DO_ATTN); bf16* zbuf = (bf16*)(dout_b + DO_Z); bf16* zg = (bf16*)(dout_b + DO_ZG);
    float2* lamb = (float2*)(ws + WS_PAR + PAR_LAMB); float2* lamL = (float2*)(ws + WS_PAR + PAR_LAML); float2* bbar = (float2*)(ws + WS_PAR + PAR_BBAR);
    u32x4* bbt = (u32x4*)(ws + WS_PAR + PAR_BBT); u32x4* cmt = (u32x4*)(ws + WS_PAR + PAR_CMT); float2* sse = (float2*)(ws + WS_SSE);
    bf16* rwh = (bf16*)(ws + WS_PAR + PAR_RWH); bf16* rwl = (bf16*)(ws + WS_PAR + PAR_RWL);
    int2* lists = (int2*)(ws + WS_LIST);
    int* tok_e = (int*)(ws + WS_TOK + TOK_E); int* tok_slot = (int*)(ws + WS_TOK + TOK_SLOT); float* tok_w = (float*)(ws + WS_TOK + TOK_W); float* tok_inv = (float*)(ws + WS_TOK + TOK_INV);
    unsigned* ecnt = ctl + CW_CNT;
    const int lo = args.ph_lo, hi = args.ph_hi;
#define IN(k) (lo <= (k) && (k) < hi)
#define BOTH(k, k2) (IN(k) && IN(k2))
    if (threadIdx.x < 4) ((LAS unsigned*)(ldsp + LDS_BARW))[threadIdx.x] = 0u;
    __syncthreads();
    XcdBarrier gbar; gbar.bar = ctl + CW_BAR; gbar.x = 0; gbar.st = nullptr;
    if (hi - lo > 1) gbar = xcd_barrier_post(ctl + CW_BAR, (volatile LAS unsigned*)(ldsp + LDS_BARW));
#define GRID_BAR(k, k2) do { if (BOTH(k, k2)) xcd_barrier(gbar); } while (0)

    constexpr int CV_IN = (D / 64) * (INC / 32), CV_GLU = (DSSM / 64) * (DSSM / 32), CV_A = (DATT / 64) * (D / 32), CV_S = (DSSM / 64) * (D / 32), CV_O = (D / 64) * (D / 32);
    constexpr int CV_EG = (D / 64) * (DFF / 32), CV_ED = (DFF / 64) * (D / 32);
    constexpr int CV_ALL = CV_IN + CV_GLU + CV_A + CV_S + CV_O + NE * (2 * CV_EG + CV_ED);
    auto cv_decode = [&](int r) __attribute__((always_inline)) -> CvDesc {
        CvDesc d; d.ksc = nullptr;
        if (r < CV_IN) { const int nb = INC / 32, k0 = 64 * (r / nb), n0 = 32 * (r % nb); d.W = args.in[2] + (size_t)k0 * INC + n0; d.N = INC; d.K = D; d.dst = WinT + (size_t)n0 * D + k0; return d; } r -= CV_IN;
        if (r < CV_GLU) { const int nb = DSSM / 32, k0 = 64 * (r / nb), n0 = 32 * (r % nb); d.W = args.in[13] + (size_t)k0 * DSSM + n0; d.N = DSSM; d.K = DSSM; d.dst = WgluT + (size_t)n0 * DSSM + k0; return d; } r -= CV_GLU;
        if (r < CV_A) { const int nb = D / 32, k0 = 64 * (r / nb), n0 = 32 * (r % nb); d.W = args.in[15] + (size_t)k0 * D + n0; d.N = D; d.K = DATT; d.dst = WaT + (size_t)n0 * DATT + k0; return d; } r -= CV_A;
        if (r < CV_S) { const int nb = D / 32, k0 = 64 * (r / nb), n0 = 32 * (r % nb); d.W = args.in[16] + (size_t)k0 * D + n0; d.N = D; d.K = DSSM; d.dst = WsT + (size_t)n0 * DSSM + k0; return d; } r -= CV_S;
        if (r < CV_O) { const int nb = D / 32, k0 = 64 * (r / nb), n0 = 32 * (r % nb); d.W = args.in[17] + (size_t)k0 * D + n0; d.N = D; d.K = D; d.dst = WoutT + (size_t)n0 * D + k0; return d; } r -= CV_O;
        if (r < NE * 2 * CV_EG) { const int e = r / (2 * CV_EG); r -= e * (2 * CV_EG); const int up = r >= CV_EG; if (up) r -= CV_EG; const int nb = DFF / 32, k0 = 64 * (r / nb), n0 = 32 * (r % nb);
            const int np0 = 256 * (n0 >> 7) + (n0 & 127) + (up ? 128 : 0);
            d.W = (up ? args.in[24] : args.in[23]) + ((size_t)e * D + k0) * DFF + n0; d.N = DFF; d.K = D; d.dst = WguT + ((size_t)e * 1024 + np0) * D + k0; d.ksc = args.in[18] + k0; return d; }
        r -= NE * 2 * CV_EG;
        { const int e = r / CV_ED; r -= e * CV_ED; const int nb = D / 32, k0 = 64 * (r / nb), n0 = 32 * (r % nb); d.W = args.in[25] + ((size_t)e * DFF + k0) * D + n0; d.N = D; d.K = DFF; d.dst = WdT + ((size_t)e * D + n0) * DFF + k0; }
        return d;
    };
    auto cv_run = [&](int first, int stride, int count, LAS float* scr, int lane) __attribute__((always_inline)) {
        if (count <= 0) return;
        f32x4 t0[8], t1[8], t2[8], t3[8];
        CvDesc d0 = cv_decode(first), d1 = d0, d2 = d0, d3 = d0;
        cv_load(d0, lane, t0);
        if (count > 1) { d1 = cv_decode(first + stride); cv_load(d1, lane, t1); }
        if (count > 2) { d2 = cv_decode(first + 2 * stride); cv_load(d2, lane, t2); }
#pragma unroll 1
        for (int j = 0; j < count; j += 4) {
            if (j + 3 < count) { d3 = cv_decode(first + (j + 3) * stride); cv_load(d3, lane, t3); }
            cv_finish(d0, lane, t0, scr);
            if (j + 4 < count) { d0 = cv_decode(first + (j + 4) * stride); cv_load(d0, lane, t0); }
            if (j + 1 < count) cv_finish(d1, lane, t1, scr);
            if (j + 5 < count) { d1 = cv_decode(first + (j + 5) * stride); cv_load(d1, lane, t1); }
            if (j + 2 < count) cv_finish(d2, lane, t2, scr);
            if (j + 6 < count) { d2 = cv_decode(first + (j + 6) * stride); cv_load(d2, lane, t2); }
            if (j + 3 < count) cv_finish(d3, lane, t3, scr);
        }
    };

    auto make_tables = [&](const long tfirst, const long tstep) __attribute__((always_inline)) {
        for (long i = tfirst; i < 48 * D; i += tstep) { const int n = (int)(i / D), k = (int)(i % D);
            const float wv = (n < NEG) ? args.in[19][(size_t)k * NEG + n] : (n < NEG + NE) ? args.in[21][(size_t)k * NE + (n - NEG)] : 0.f;
            const bf16 hb = f2bf(wv); rwh[i] = hb; rwl[i] = f2bf(wv - bf2f(hb)); }
        for (long i = tfirst; i < NG * 4 * 64; i += tstep) { const int l = (int)(i & 63), t = (int)((i >> 6) & 3), g = (int)(i >> 8);
            { const int p = (t >> 1) * 32 + (l & 31), part = t & 1; const int gp = g * PS + p;
              const double are = (double)args.in[5][gp], aim = (double)args.in[6][gp], dt = dexp_((double)args.in[12][g]);
              double s, c; dsincos_(aim * dt, s, c); const double er = dexp_(are * dt); const double lr = er * c, li = er * s;
              const double nx = lr - 1.0, ny = li, den = are * are + aim * aim; const double cr = (nx * are + ny * aim) / den, ci = (ny * are - nx * aim) / den;
              unsigned wv[4];
#pragma unroll
              for (int i2 = 0; i2 < 4; ++i2) { float v2[2];
#pragma unroll
                  for (int q = 0; q < 2; ++q) { const int cc = 8 * (l >> 5) + 2 * i2 + q; const double br = (double)args.in[7][gp * GC + cc], bi = (double)args.in[8][gp * GC + cc];
                      v2[q] = part ? (float)(cr * bi + ci * br) : (float)(cr * br - ci * bi); }
                  wv[i2] = (unsigned)f2bf(v2[0]) | ((unsigned)f2bf(v2[1]) << 16); }
              u32x4 o; o.x = wv[0]; o.y = wv[1]; o.z = wv[2]; o.w = wv[3]; bbt[i] = o; }
            { const int ks = t, c = l & 15; unsigned wv[4];
#pragma unroll
              for (int i2 = 0; i2 < 4; ++i2) { float v2[2];
#pragma unroll
                  for (int q = 0; q < 2; ++q) { const int kk = ks * 32 + 8 * (l >> 4) + 2 * i2 + q; const int jj = kk >> 2, qq = kk & 3; const int p = jj + 32 * (qq >> 1);
                      v2[q] = (qq & 1) ? -args.in[10][(g * GC + c) * PS + p] : args.in[9][(g * GC + c) * PS + p]; }
                  wv[i2] = (unsigned)f2bf(v2[0]) | ((unsigned)f2bf(v2[1]) << 16); }
              u32x4 o; o.x = wv[0]; o.y = wv[1]; o.z = wv[2]; o.w = wv[3]; cmt[i] = o; } }
        for (long i = tfirst; i < NG * PS; i += tstep) { const int g = (int)(i / PS);
            const double are = (double)args.in[5][i], aim = (double)args.in[6][i], dt = dexp_((double)args.in[12][g]);
            double s, c; dsincos_(aim * dt, s, c); const double er = dexp_(are * dt); const double lr = er * c, li = er * s;
            lamb[i] = make_float2((float)lr, (float)li);
            double sL, cL; dsincos_(aim * dt * LSUB, sL, cL); const double eL = dexp_(are * dt * LSUB); lamL[i] = make_float2((float)(eL * cL), (float)(eL * sL));
            const double nx = lr - 1.0, ny = li, den = are * are + aim * aim; const double cr = (nx * are + ny * aim) / den, ci = (ny * are - nx * aim) / den;
#pragma unroll
            for (int cc = 0; cc < GC; ++cc) { const double br = (double)args.in[7][i * GC + cc], bi = (double)args.in[8][i * GC + cc];
                bbar[i * GC + cc] = make_float2((float)(cr * br - ci * bi), (float)(cr * bi + ci * br)); } }
    };

    if (IN(0)) {
        PH_IDX
#if FAST_P0
        {
            LAS float* scr = (LAS float*)(ldsp + wave * 8448);
            cv_run(gw, NW, (CV_IN + CV_P0X - gw + NW - 1) / NW, scr, lane);
        }
        { const float* g = args.in[1]; f32x4 gv[4];
#pragma unroll
          for (int j = 0; j < 4; ++j) gv[j] = *(const f32x4*)(g + 256 * j + 4 * lane);
          f32x4 vn[4];
          if (gw < M) {
#pragma unroll
              for (int j = 0; j < 4; ++j) vn[j] = __builtin_nontemporal_load((const f32x4*)(x + (size_t)gw * D + 256 * j + 4 * lane)); }
#pragma unroll 1
          for (int m = gw; m < M; m += NW) { f32x4 v[4]; float ss = 0.f;
#pragma unroll
              for (int j = 0; j < 4; ++j) v[j] = vn[j];
              if (m + NW < M) {
#pragma unroll
                  for (int j = 0; j < 4; ++j) vn[j] = __builtin_nontemporal_load((const f32x4*)(x + (size_t)(m + NW) * D + 256 * j + 4 * lane)); }
#pragma unroll
              for (int j = 0; j < 4; ++j) ss += v[j][0] * v[j][0] + v[j][1] * v[j][1] + v[j][2] * v[j][2] + v[j][3] * v[j][3];
              const float inv = 1.f / sqrtf(wave_sum(ss) * (1.f / D) + EPS);
#pragma unroll
              for (int j = 0; j < 4; ++j) { const f32x4 t = v[j] * inv * gv[j]; unsigned long long o = (unsigned long long)pk2(t[0], t[1]) | ((unsigned long long)pk2(t[2], t[3]) << 32);
                  *(unsigned long long*)(hbuf + (size_t)m * D + 256 * j + 4 * lane) = o; } } }
#else
        { const float* W = args.in[2]; for (long i = gt; i < (long)INC * D; i += NT) { const int n = (int)(i / D), k = (int)(i % D); WinT[i] = f2bf(W[(size_t)k * INC + n]); } }
        { const float* W = args.in[13]; for (long i = gt; i < (long)DSSM * DSSM; i += NT) { const int n = (int)(i / DSSM), k = (int)(i % DSSM); WgluT[i] = f2bf(W[(size_t)k * DSSM + n]); } }
        { const float* W = args.in[15]; for (long i = gt; i < (long)D * DATT; i += NT) { const int n = (int)(i / DATT), k = (int)(i % DATT); WaT[i] = f2bf(W[(size_t)k * D + n]); } }
        { const float* W = args.in[16]; for (long i = gt; i < (long)D * DSSM; i += NT) { const int n = (int)(i / DSSM), k = (int)(i % DSSM); WsT[i] = f2bf(W[(size_t)k * D + n]); } }
        { const float* W = args.in[17]; for (long i = gt; i < (long)D * D; i += NT) { const int n = (int)(i / D), k = (int)(i % D); WoutT[i] = f2bf(W[(size_t)k * D + n]); } }
        { const float* Wg = args.in[23]; const float* Wu = args.in[24];
          for (long i = gt; i < (long)NE * 1024 * D; i += NT) { const int k = (int)(i % D); const int np = (int)((i / D) % 1024); const int e = (int)(i / ((long)D * 1024));
              const int pn = np >> 8, bj = (np >> 7) & 1, jj = np & 127; const float* W = bj ? Wu : Wg;
              WguT[i] = f2bf(W[((size_t)e * D + k) * DFF + 128 * pn + jj]); } }
        { const float* W = args.in[25];
          for (long i = gt; i < (long)NE * D * DFF; i += NT) { const int k = (int)(i % DFF); const int n = (int)((i / DFF) % D); const int e = (int)(i / ((long)DFF * D));
              WdT[i] = f2bf(W[((size_t)e * DFF + k) * D + n]); } }
        { const float* g = args.in[1];
          for (int m = gw; m < M; m += NW) { const float* xr = x + (size_t)m * D; float v[16]; float ss = 0.f;
#pragma unroll
              for (int j = 0; j < 4; ++j) { const f32x4 t = *(const f32x4*)(xr + 256 * j + 4 * lane); v[4 * j] = t[0]; v[4 * j + 1] = t[1]; v[4 * j + 2] = t[2]; v[4 * j + 3] = t[3]; ss += t[0] * t[0] + t[1] * t[1] + t[2] * t[2] + t[3] * t[3]; }
              const float inv = 1.f / sqrtf(wave_sum(ss) * (1.f / D) + EPS);
#pragma unroll
              for (int j = 0; j < 4; ++j)
#pragma unroll
                  for (int i = 0; i < 4; ++i) { const int k = 256 * j + 4 * lane + i; hbuf[(size_t)m * D + k] = f2bf(v[4 * j + i] * inv * g[k]); } } }
#endif
    }

    GRID_BAR(0, 1);
#if FAST_P1
    if (IN(1)) {
        const bool split = (int)gridDim.x == 256;
        const int NGW = split ? CV_NGW : (int)gridDim.x;
        if ((int)blockIdx.x < NGW) {
            pg8::DenseSched S; S.so.init(M, INC, NGW, (int)blockIdx.x); S.A = (const char*)hbuf; S.B = (const char*)WinT; S.astep = (size_t)256 * D * 2; S.bstep = (size_t)256 * D * 2;
            S.nfull = (S.so.nwg / S.so.G) * S.so.G;
            pg8::EpiProj E{qkvu, gates, args.in[3]};
            pg8::gemm_phase<pg8::EpiProj, pg8::DenseSched, false, true>(ldsp, D, D, D, S, E, nullptr);
        }
        {   int tq = (int)threadIdx.x; asm volatile("" : "+v"(tq));
            const int lane = tq & 63, wave = __builtin_amdgcn_readfirstlane(tq >> 6), gw = (int)blockIdx.x * NWAVES + wave, NW = (int)gridDim.x * NWAVES;
            LAS float* scr = (LAS float*)(ldsp + wave * 8448);
            const int nsw = ((int)gridDim.x - NGW) * NWAVES;
            int done = CV_IN + CV_P0X;
            if (split) {
                if ((int)blockIdx.x >= NGW) { const int sw = ((int)blockIdx.x - NGW) * NWAVES + wave; cv_run(done + sw, nsw, CV_STREAM_J, scr, lane);
                    const int tbn = (int)gridDim.x - NGW; make_tables((long)tq * tbn + ((int)blockIdx.x - NGW), (long)tbn * NTHREADS); }
                done += CV_STREAM_J * nsw;
            }
            if (split && CV_TAIL_J > 0) {
                const int nhalfw = 2 * (13 * 64 - (13 * 64 / NGW) * NGW), ntw = NGW - nhalfw;
                if ((int)blockIdx.x >= nhalfw && (int)blockIdx.x < NGW) cv_run(done + ((int)blockIdx.x - nhalfw) * NWAVES + wave, ntw * NWAVES, CV_TAIL_J, scr, lane);
                done += CV_TAIL_J * ntw * NWAVES;
            }
            cv_run(done + gw, NW, (CV_ALL - CV_P8X - done - gw + NW - 1) / NW, scr, lane);
            if (!split || nsw == 0) make_tables((long)tq * gridDim.x + blockIdx.x, (long)gridDim.x * NTHREADS);
        }
    }

#else
    if (IN(1)) {
        PH_IDX
        const float* bg = args.in[3];
        naive_gemm(hbuf, D, WinT, D, M, INC, D, [&](int m, int n, float acc) {
            if (n < QKVU_LD) qkvu[(size_t)m * QKVU_LD + n] = f2bf(acc);
            else gates[(size_t)m * GATEC + (n - QKVU_LD)] = f2bf(sigmoidf_(acc + bg[n - QKVU_LD])); }, gt, NT);
    }

#endif
    GRID_BAR(1, 2);
    if (IN(2)) {
        PH_IDX
#if FAST_ATT
#else
        const float* sinks = args.in[4];
        for (int task = gw; task < M * NH; task += NW) {
            const int h = task % NH, row = task / NH, t = row % SEQ, kvh = h / 4;
            const bf16* q = qkvu + (size_t)row * QKVU_LD + QOFF + h * HD;
            const float sink = sinks[h];
            const int t0 = t - lane, t1 = t - 64 - lane;
            float s0 = -3.0e38f, s1 = -3.0e38f;
            if (t0 >= 0) { const bf16* k = qkvu + (size_t)(row - lane) * QKVU_LD + KOFF + kvh * HD; float a = 0.f;
#pragma unroll
                for (int d8 = 0; d8 < 8; ++d8) a += dot8(*(const u32x4*)(q + 8 * d8), *(const u32x4*)(k + 8 * d8));
                s0 = a * 0.125f; }
            if (t1 >= 0) { const bf16* k = qkvu + (size_t)(row - 64 - lane) * QKVU_LD + KOFF + kvh * HD; float a = 0.f;
#pragma unroll
                for (int d8 = 0; d8 < 8; ++d8) a += dot8(*(const u32x4*)(q + 8 * d8), *(const u32x4*)(k + 8 * d8));
                s1 = a * 0.125f; }
            const float mx = fmaxf(wave_max(fmaxf(s0, s1)), sink);
            const float p0 = (t0 >= 0) ? __expf(s0 - mx) : 0.f, p1 = (t1 >= 0) ? __expf(s1 - mx) : 0.f;
            const float denom = wave_sum(p0 + p1) + __expf(sink - mx);
            float o = 0.f;
            for (int j = 0; j < 64; ++j) { const float pj = __shfl(p0, j); if (t - j >= 0) o += pj * bf2f(qkvu[(size_t)(row - j) * QKVU_LD + VOFF + kvh * HD + lane]); }
            for (int j = 0; j < 64; ++j) { const float pj = __shfl(p1, j); if (t - 64 - j >= 0) o += pj * bf2f(qkvu[(size_t)(row - 64 - j) * QKVU_LD + VOFF + kvh * HD + lane]); }
            attn[(size_t)row * DATT + h * HD + lane] = f2bf(o / denom);
        }
#endif
#if FAST_S5
        for (int un = (int)blockIdx.x; un < 256; un += (int)gridDim.x) {
            u32x4 kvreg[8]; att::load_kv(un, qkvu, kvreg);
            s5::run<false>(un, qkvu, bbt, cmt, lamb, lamL, sse, args.in[11], zbuf, ldsp);
            att::unit(un, qkvu, args.in[4], attn, ldsp, kvreg);
        }
#else
        const float* cre = args.in[9]; const float* cim = args.in[10]; const float* dsk = args.in[11];
        for (int bgi = gw; bgi < BATCH * NG; bgi += NW) {
            const int b = bgi / NG, g = bgi % NG;
            const float2 lam = lamb[g * PS + lane];
            float br[GC], bi[GC], cr[GC], ci[GC];
#pragma unroll
            for (int c = 0; c < GC; ++c) { const float2 bb = bbar[(g * PS + lane) * GC + c]; br[c] = bb.x; bi[c] = bb.y; cr[c] = cre[(g * GC + c) * PS + lane]; ci[c] = cim[(g * GC + c) * PS + lane]; }
            const float dmine = dsk[g * GC + (lane & 15)];
            float sr = 0.f, si = 0.f;
            for (int t = 0; t < SEQ; ++t) {
                const size_t row = (size_t)b * SEQ + t;
                const bf16* up = qkvu + row * QKVU_LD + UOFF + g * GC;
                const u32x4 ua = *(const u32x4*)up, ub = *(const u32x4*)(up + 8);
                float u[GC];
#pragma unroll
                for (int j = 0; j < 4; ++j) { u[2 * j] = __uint_as_float(ua[j] << 16); u[2 * j + 1] = __uint_as_float(ua[j] & 0xffff0000u); u[8 + 2 * j] = __uint_as_float(ub[j] << 16); u[8 + 2 * j + 1] = __uint_as_float(ub[j] & 0xffff0000u); }
                float bur = 0.f, bui = 0.f;
#pragma unroll
                for (int c = 0; c < GC; ++c) { bur += br[c] * u[c]; bui += bi[c] * u[c]; }
                const float nsr = lam.x * sr - lam.y * si + bur, nsi = lam.x * si + lam.y * sr + bui; sr = nsr; si = nsi;
                float ymine = 0.f, umine = 0.f;
#pragma unroll
                for (int c = 0; c < GC; ++c) { const float yc = wave_sum(cr[c] * sr - ci[c] * si); if ((lane & 15) == c) { ymine = yc; umine = u[c]; } }
                if (lane < GC) zbuf[row * DSSM + g * GC + lane] = f2bf(gelu_tanh(ymine + dmine * umine));
            }
        }
    #endif
    }
#if FAST_S5
    GRID_BAR(2, 3);
    if (IN(3)) {
        for (int un = (int)blockIdx.x; un < 256; un += (int)gridDim.x)
            s5::run<true>(un, qkvu, bbt, cmt, lamb, lamL, sse, args.in[11], zbuf, ldsp);
    }
#endif

    GRID_BAR(3, 4);
#if FAST_P4
    if (IN(4)) {
        pg8::DenseSched S; S.so.init(M, DSSM, (int)gridDim.x, (int)blockIdx.x); S.A = (const char*)zbuf; S.B = (const char*)WgluT; S.astep = (size_t)256 * DSSM * 2; S.bstep = (size_t)256 * DSSM * 2;
        S.nfull = 0;
        pg8::EpiGlu E{zbuf, zg, args.in[14]};
        pg8::gemm_phase<pg8::EpiGlu, pg8::DenseSched, false, true>(ldsp, DSSM, DSSM, DSSM, S, E, nullptr);
    }
#else
    if (IN(4)) {
        PH_IDX
        const float* bgl = args.in[14];
        naive_gemm(zbuf, DSSM, WgluT, DSSM, M, DSSM, DSSM, [&](int m, int n, float acc) {
            zg[(size_t)m * DSSM + n] = f2bf(bf2f(zbuf[(size_t)m * DSSM + n]) * sigmoidf_(acc + bgl[n])); }, gt, NT);
    }
#endif
    GRID_BAR(4, 5);
#if FAST_P5
    if (IN(5)) {
        pg8::BranchSched S; S.so.init(M, D, (int)gridDim.x, (int)blockIdx.x); S.A1 = (const char*)attn; S.B1 = (const char*)WaT; S.A2 = (const char*)zg; S.B2 = (const char*)WsT;
        pg8::EpiBranch2 E{gates, merged};
        pg8::gemm_phase<pg8::EpiBranch2, pg8::BranchSched, false, false, true>(ldsp, DSSM, DSSM, DSSM, S, E, nullptr);
    }
#else
    if (IN(5)) {
        PH_IDX
        for (long idx = gt; idx < (long)M * D; idx += NT) {
            const int m = (int)(idx / D), n = (int)(idx % D);
            const u32x4* a1 = (const u32x4*)(attn + (size_t)m * DATT); const u32x4* b1 = (const u32x4*)(WaT + (size_t)n * DATT);
            const u32x4* a2 = (const u32x4*)(zg + (size_t)m * DSSM); const u32x4* b2 = (const u32x4*)(WsT + (size_t)n * DSSM);
            float s1 = 0.f, s2 = 0.f;
#pragma unroll 4
            for (int k8 = 0; k8 < DATT / 8; ++k8) { s1 += dot8(a1[k8], b1[k8]); s2 += dot8(a2[k8], b2[k8]); }
            const float ga = bf2f(gates[(size_t)m * GATEC + n]), gs = bf2f(gates[(size_t)m * GATEC + D + n]);
            merged[idx] = f2bf(ga * s1 + gs * s2);
        }
    }
#endif
    GRID_BAR(5, 6);
#if FAST_P6
    if (IN(6)) {
        pg8::DenseSched S; S.so.init(M, D, (int)gridDim.x, (int)blockIdx.x); S.A = (const char*)merged; S.B = (const char*)WoutT; S.astep = (size_t)256 * D * 2; S.bstep = (size_t)256 * D * 2;
        pg8::EpiDelta E{delta};
        pg8::gemm_phase<pg8::EpiDelta, pg8::DenseSched, false>(ldsp, D, D, D, S, E, nullptr);
    }
#else
    if (IN(6)) {
        PH_IDX
        naive_gemm(merged, D, WoutT, D, M, D, D, [&](int m, int n, float acc) { out[(size_t)m * D + n] = x[(size_t)m * D + n] + acc; }, gt, NT);
    }
#endif
    GRID_BAR(6, 7);
#if FAST_P7
    if (IN(7)) {
        typedef short bf16x8_ __attribute__((ext_vector_type(8)));
        const int tid = threadIdx.x, lane = tid & 63, wave = __builtin_amdgcn_readfirstlane(tid >> 6), row = lane & 15, kg = lane >> 4;
        const float* g2 = args.in[18]; const float* brg = args.in[20]; const float* bre = args.in[22];
        LAS float* PL = (LAS float*)ldsp;
        LAS float* SSP = PL + 8 * 64 * 52;
        LAS float* RL = SSP + 8 * 4 * 64;
        LAS int* cntL = (LAS int*)(RL + 64 * 40); LAS int* baseL = cntL + 32;
        if (tid < NE) cntL[tid] = 0;
        for (int tg = (int)blockIdx.x; tg < M / 64; tg += (int)gridDim.x) {
#pragma unroll 1
            for (int half = 0; half < 2; ++half) {
                bf16x8_ wh[2][3], wl[2][3]; f32x4 ga[2], gb[2];
                const int kb = 128 * wave + 64 * half + 8 * kg;
#pragma unroll
                for (int s = 0; s < 2; ++s) { ga[s] = *(const f32x4*)(g2 + kb + 32 * s); gb[s] = *(const f32x4*)(g2 + kb + 32 * s + 4);
#pragma unroll
                    for (int nt = 0; nt < 3; ++nt) { const size_t wo = (size_t)(nt * 16 + row) * D + kb + 32 * s; wh[s][nt] = __builtin_bit_cast(bf16x8_, *(const u32x4*)(rwh + wo)); wl[s][nt] = __builtin_bit_cast(bf16x8_, *(const u32x4*)(rwl + wo)); } }
#pragma unroll 1
                for (int tile = 0; tile < 4; ++tile) {
                    const int m = tg * 64 + tile * 16 + row;
                    const float* xr = x + (size_t)m * D + kb; const bf16* dr = delta + (size_t)m * D + kb;
                    f32x4 xa[2], xb[2]; u32x4 dd[2];
#pragma unroll
                    for (int s = 0; s < 2; ++s) { xa[s] = __builtin_nontemporal_load((const f32x4*)(xr + 32 * s)); xb[s] = __builtin_nontemporal_load((const f32x4*)(xr + 32 * s + 4)); dd[s] = *(const u32x4*)(dr + 32 * s); }
                    LAS float* pl = PL + ((wave * 64) + tile * 16 + 4 * kg) * 52 + row;
                    f32x4 acc[3]; float ss = 0.f;
                    if (half) { ss = SSP[(wave * 4 + tile) * 64 + lane];
#pragma unroll
                        for (int nt = 0; nt < 3; ++nt)
#pragma unroll
                            for (int r = 0; r < 4; ++r) acc[nt][r] = pl[r * 52 + nt * 16]; }
                    else { acc[0] = (f32x4){0.f, 0.f, 0.f, 0.f}; acc[1] = acc[0]; acc[2] = acc[0]; }
#pragma unroll
                    for (int s = 0; s < 2; ++s) {
                        const f32x4 va = xa[s] + pg8::bflo4(dd[s].x, dd[s].y), vb = xb[s] + pg8::bflo4(dd[s].z, dd[s].w);
                        ss += va[0] * va[0] + va[1] * va[1] + va[2] * va[2] + va[3] * va[3] + vb[0] * vb[0] + vb[1] * vb[1] + vb[2] * vb[2] + vb[3] * vb[3];
                        const f32x4 ha = va * ga[s], hb = vb * gb[s];
                        u32x4 hw; hw.x = pg8::cvt_pk_bf16(ha[0], ha[1]); hw.y = pg8::cvt_pk_bf16(ha[2], ha[3]); hw.z = pg8::cvt_pk_bf16(hb[0], hb[1]); hw.w = pg8::cvt_pk_bf16(hb[2], hb[3]);
                        { u32x4 xw; xw.x = pg8::cvt_pk_bf16(va[0], va[1]); xw.y = pg8::cvt_pk_bf16(va[2], va[3]); xw.z = pg8::cvt_pk_bf16(vb[0], vb[1]); xw.w = pg8::cvt_pk_bf16(vb[2], vb[3]);
                          *(u32x4*)(h2u + (size_t)m * D + kb + 32 * s) = xw; }
                        u32x4 lw; lw.x = pg8::cvt_pk_bf16(ha[0] - __uint_as_float(hw.x << 16), ha[1] - __uint_as_float(hw.x & 0xffff0000u)); lw.y = pg8::cvt_pk_bf16(ha[2] - __uint_as_float(hw.y << 16), ha[3] - __uint_as_float(hw.y & 0xffff0000u));
                        lw.z = pg8::cvt_pk_bf16(hb[0] - __uint_as_float(hw.z << 16), hb[1] - __uint_as_float(hw.z & 0xffff0000u)); lw.w = pg8::cvt_pk_bf16(hb[2] - __uint_as_float(hw.w << 16), hb[3] - __uint_as_float(hw.w & 0xffff0000u));
                        const bf16x8_ ahi = __builtin_bit_cast(bf16x8_, hw), alo = __builtin_bit_cast(bf16x8_, lw);
#pragma unroll
                        for (int nt = 0; nt < 3; ++nt) {
                            acc[nt] = __builtin_amdgcn_mfma_f32_16x16x32_bf16(ahi, wh[s][nt], acc[nt], 0, 0, 0); mfma_keep(ahi, wh[s][nt], acc[nt][0]);
                            acc[nt] = __builtin_amdgcn_mfma_f32_16x16x32_bf16(alo, wh[s][nt], acc[nt], 0, 0, 0); mfma_keep(alo, wh[s][nt], acc[nt][0]);
                            acc[nt] = __builtin_amdgcn_mfma_f32_16x16x32_bf16(ahi, wl[s][nt], acc[nt], 0, 0, 0); mfma_keep(ahi, wl[s][nt], acc[nt][0]); }
                    }
                    SSP[(wave * 4 + tile) * 64 + lane] = ss;
#pragma unroll
                    for (int nt = 0; nt < 3; ++nt)
#pragma unroll
                        for (int r = 0; r < 4; ++r) pl[r * 52 + nt * 16] = acc[nt][r];
                }
            }
            __syncthreads();
#pragma unroll 1
            for (int idx = tid; idx < 64 * 37; idx += NTHREADS) { const int tok = idx / 37, i = idx - tok * 37; float sacc = 0.f;
                if (i < 36) {
#pragma unroll
                    for (int w8 = 0; w8 < 8; ++w8) sacc += PL[(w8 * 64 + tok) * 52 + i]; }
                else {
#pragma unroll
                    for (int w8 = 0; w8 < 8; ++w8)
#pragma unroll
                        for (int q4 = 0; q4 < 4; ++q4) sacc += SSP[(w8 * 4 + (tok >> 4)) * 64 + q4 * 16 + (tok & 15)]; }
                RL[tok * 40 + i] = sacc; }
            __syncthreads();
            int tq = (int)threadIdx.x; asm volatile("" : "+v"(tq));
            const bool router_lane = tq < 64; const int mt = tg * 64 + (tq & 63);
            int ex0 = 0, ex1 = 0, rk0 = 0, rk1 = 0; float w0 = 0.f, w1 = 0.f, inv = 0.f;
            if (router_lane) {
                const int tok = tq;
                inv = 1.f / sqrtf(RL[tok * 40 + 36] * (1.f / D) + EPS);
                float lg[36];
#pragma unroll
                for (int i = 0; i < 36; ++i) lg[i] = RL[tok * 40 + i] * inv;
                float gl[4];
#pragma unroll
                for (int i = 0; i < 4; ++i) gl[i] = lg[i] + brg[i];
                int gi = 0; float gm = gl[0];
#pragma unroll
                for (int i = 1; i < 4; ++i) if (gl[i] > gm) { gm = gl[i]; gi = i; }
                float gsum = 0.f;
#pragma unroll
                for (int i = 0; i < 4; ++i) gsum += __expf(gl[i] - gm);
                const float group_p = 1.f / gsum;
                float sel[8];
#pragma unroll
                for (int i = 0; i < 8; ++i) { float sv = 0.f;
#pragma unroll
                    for (int q = 0; q < 4; ++q) if (gi == q) sv = lg[4 + 8 * q + i] + bre[8 * q + i];
                    sel[i] = sv; }
                int i0 = 0; float m0 = sel[0];
#pragma unroll
                for (int i = 1; i < 8; ++i) if (sel[i] > m0) { m0 = sel[i]; i0 = i; }
                int i1 = -1; float m1 = -3.0e38f;
#pragma unroll
                for (int i = 0; i < 8; ++i) if (i != i0 && sel[i] > m1) { m1 = sel[i]; i1 = i; }
                const float e1 = __expf(m1 - m0);
                w0 = group_p / (1.f + e1); w1 = group_p * e1 / (1.f + e1);
                ex0 = gi * EPG + i0; ex1 = gi * EPG + i1;
                rk0 = __hip_atomic_fetch_add(&cntL[ex0], 1, __ATOMIC_RELAXED, __HIP_MEMORY_SCOPE_WORKGROUP); rk1 = __hip_atomic_fetch_add(&cntL[ex1], 1, __ATOMIC_RELAXED, __HIP_MEMORY_SCOPE_WORKGROUP);
            }
            __syncthreads();
            if (tq < NE) { const int c = cntL[tq]; baseL[tq] = c ? (int)atomicAdd(&ecnt[64 * tq], (unsigned)c) : 0; cntL[tq] = 0; }
            __syncthreads();
            if (router_lane) {
                const int sl0 = baseL[ex0] + rk0, sl1 = baseL[ex1] + rk1;
                lists[(size_t)ex0 * M + sl0] = make_int2(2 * mt, __float_as_int(inv)); lists[(size_t)ex1 * M + sl1] = make_int2(2 * mt + 1, __float_as_int(inv));
                tok_e[2 * mt] = ex0; tok_e[2 * mt + 1] = ex1; tok_slot[2 * mt] = sl0; tok_slot[2 * mt + 1] = sl1; tok_w[2 * mt] = w0; tok_w[2 * mt + 1] = w1; tok_inv[mt] = inv;
            }
        }
    }
#else
    if (IN(7)) {
        PH_IDX
        const float* g2 = args.in[18]; const float* wrg = args.in[19]; const float* brg = args.in[20]; const float* wre = args.in[21]; const float* bre = args.in[22];
        for (int m = gw; m < M; m += NW) {
            const float* xr = out + (size_t)m * D; float ss = 0.f;
#pragma unroll
            for (int j = 0; j < 4; ++j) { const f32x4 t = *(const f32x4*)(xr + 256 * j + 4 * lane); ss += t[0] * t[0] + t[1] * t[1] + t[2] * t[2] + t[3] * t[3]; }
            const float inv = 1.f / sqrtf(wave_sum(ss) * (1.f / D) + EPS);
            float lg[36];
#pragma unroll
            for (int i = 0; i < 36; ++i) lg[i] = 0.f;
#pragma unroll 1
            for (int kk = 0; kk < 16; ++kk) { const int k = 256 * (kk >> 2) + 4 * lane + (kk & 3); const float hv = xr[k] * g2[k]; h2u[(size_t)m * D + k] = f2bf(hv); const float hn = hv * inv;
                const f32x4 w4 = *(const f32x4*)(wrg + (size_t)k * NEG); lg[0] += hn * w4[0]; lg[1] += hn * w4[1]; lg[2] += hn * w4[2]; lg[3] += hn * w4[3];
#pragma unroll
                for (int q = 0; q < 8; ++q) { const f32x4 w = *(const f32x4*)(wre + (size_t)k * NE + 4 * q); lg[4 + 4 * q] += hn * w[0]; lg[5 + 4 * q] += hn * w[1]; lg[6 + 4 * q] += hn * w[2]; lg[7 + 4 * q] += hn * w[3]; } }
#pragma unroll
            for (int i = 0; i < 36; ++i) lg[i] = wave_sum(lg[i]);
            float gl[4];
#pragma unroll
            for (int i = 0; i < 4; ++i) gl[i] = lg[i] + brg[i];
            int gi = 0; float gm = gl[0];
#pragma unroll
            for (int i = 1; i < 4; ++i) if (gl[i] > gm) { gm = gl[i]; gi = i; }
            float gsum = 0.f;
#pragma unroll
            for (int i = 0; i < 4; ++i) gsum += __expf(gl[i] - gm);
            const float group_p = 1.f / gsum;
            float sel[8];
#pragma unroll
            for (int i = 0; i < 8; ++i) { float s = 0.f;
#pragma unroll
                for (int q = 0; q < 4; ++q) if (gi == q) s = lg[4 + 8 * q + i] + bre[8 * q + i];
                sel[i] = s; }
            int i0 = 0; float m0 = sel[0];
#pragma unroll
            for (int i = 1; i < 8; ++i) if (sel[i] > m0) { m0 = sel[i]; i0 = i; }
            int i1 = -1; float m1 = -3.0e38f;
#pragma unroll
            for (int i = 0; i < 8; ++i) if (i != i0 && sel[i] > m1) { m1 = sel[i]; i1 = i; }
            const float e1 = __expf(m1 - m0);
            const float w0 = group_p / (1.f + e1), w1 = group_p * e1 / (1.f + e1);
            if (lane == 0) {
                const int ex0 = gi * EPG + i0, ex1 = gi * EPG + i1;
                const int sl0 = (int)atomicAdd(&ecnt[64 * ex0], 1u), sl1 = (int)atomicAdd(&ecnt[64 * ex1], 1u);
                lists[(size_t)ex0 * M + sl0] = make_int2(2 * m, __float_as_int(inv)); lists[(size_t)ex1 * M + sl1] = make_int2(2 * m + 1, __float_as_int(inv));
                tok_e[2 * m] = ex0; tok_e[2 * m + 1] = ex1; tok_slot[2 * m] = sl0; tok_slot[2 * m + 1] = sl1; tok_w[2 * m] = w0; tok_w[2 * m + 1] = w1; tok_inv[m] = inv;
            }
        }
    }
#endif
    GRID_BAR(7, 8);
#if FAST_MOE
#define MOE_SETUP(PH8) \
        const int tid = threadIdx.x; \
        LAS int* ttab = (LAS int*)(ldsp + LDS_TILETAB); LAS int* cntl = (LAS int*)(ldsp + LDS_MISC); LAS int* rbase = (LAS int*)(ldsp + LDS_MISC + 256); LAS int* rowtab = (LAS int*)(ldsp + LDS_ROWTAB); \
        __syncthreads(); \
        if (tid < NE) cntl[tid] = (int)ecnt[64 * tid]; \
        __syncthreads(); \
        if (tid < 33) { int s = 0; for (int q = 0; q < tid; ++q) s += cntl[q]; rbase[tid] = s; } \
        if (tid >= 64 && tid < 64 + NE) { const int q = tid - 64; const int c = cntl[q], nf = c >> 8, rem_ = c & 255; int fb = 0, tot = 0, rank = 0, nrag = 0; \
            for (int q2 = 0; q2 < NE; ++q2) { const int c2 = cntl[q2], nf2 = c2 >> 8, rem2 = c2 & 255; tot += nf2; if (q2 < q) fb += nf2; \
                if (rem2 > 0) { ++nrag; if (rem2 > rem_ || (rem2 == rem_ && q2 < q)) ++rank; } } \
            for (int r_ = 0; r_ < nf; ++r_) ttab[fb + r_] = (q << 8) | r_; \
            if (rem_) ttab[tot + rank] = (q << 8) | nf; \
            if (q == 0) ttab[160] = tot + nrag; } \
        __syncthreads(); \
        pg8::MoeSched S; S.tpre = ttab; S.rbase = rbase; S.U = 4 * ttab[160]; S.G = (int)gridDim.x; S.c = (int)blockIdx.x; \
        if (PH8) { S.A = (const char*)h2u; S.B = (const char*)WguT; S.bstepE = (size_t)1024 * D * 2; S.bstepN = (size_t)256 * D * 2; S.arow = 0; S.gather = true; } \
        else { S.A = (const char*)act; S.B = (const char*)WdT; S.bstepE = (size_t)D * DFF * 2; S.bstepN = (size_t)256 * DFF * 2; S.arow = (size_t)DFF * 2; S.gather = false; } \
        { const int hf_ = tid >> 8, r_ = tid & 255; pg8::Unit ua_, ub_; const bool ha_ = S.next(hf_, ua_), hb_ = S.next(2 + hf_, ub_);     \
          int ea_ = 0, eb_ = 0; float va_ = 0.f, vb_ = 0.f; int2 la_ = make_int2(0, 0), lb_ = la_; \
          if (ha_) la_ = lists[(size_t)ua_.aux * M + ua_.rt * 256 + (r_ < ua_.nrows ? r_ : 0)]; \
          if (hb_) lb_ = lists[(size_t)ub_.aux * M + ub_.rt * 256 + (r_ < ub_.nrows ? r_ : 0)]; \
          ea_ = la_.x; eb_ = lb_.x; \
          if (ha_) va_ = (PH8) ? __int_as_float(la_.y) : tok_w[ea_];            \
          if (hb_) vb_ = (PH8) ? __int_as_float(lb_.y) : tok_w[eb_]; \
          if (ha_) { rowtab[2 * (hf_ * 256 + r_)] = (PH8) ? (ea_ >> 1) : ea_; rowtab[2 * (hf_ * 256 + r_) + 1] = __float_as_int(va_); } \
          if (hb_) { rowtab[2 * ((2 + hf_) * 256 + r_)] = (PH8) ? (eb_ >> 1) : eb_; rowtab[2 * ((2 + hf_) * 256 + r_) + 1] = __float_as_int(vb_); } } \
        __syncthreads();
    if (IN(8)) { MOE_SETUP(true)
        pg8::EpiAct E{act, rowtab}; pg8::gemm_phase<pg8::EpiAct, pg8::MoeSched, true, true>(ldsp, D, D, D, S, E, rowtab);
        {
            int tq = (int)threadIdx.x; asm volatile("" : "+v"(tq));
            const int lane = tq & 63, wave = __builtin_amdgcn_readfirstlane(tq >> 6);
            const int ntl = ttab[160], c = (int)blockIdx.x;
            int nidleq = 64 * ((ntl + 63) / 64) - ntl, rank = c, npart = (int)gridDim.x;
            if ((int)gridDim.x == 256 && nidleq > 0) { const int q = (c & 7) * 8 + (c >> 5); rank = (q - (64 - nidleq)) * 4 + ((c >> 3) & 3); npart = 4 * nidleq; if (q < 64 - nidleq) rank = -1; }
            if (rank >= 0) { const int first = CV_ALL - CV_P8X + rank * NWAVES + wave, stride = npart * NWAVES;
                cv_run(first, stride, (CV_ALL - first + stride - 1) / stride, (LAS float*)(ldsp + wave * 8448), lane); }
        } }
    XbTicket tk89; tk89.mode = 0u; tk89.val = 0u;
    if (BOTH(8, 9)) tk89 = xcd_barrier_arrive(gbar);
    if (IN(9)) { MOE_SETUP(false)
        if (BOTH(8, 9)) xcd_barrier_wait(gbar, tk89);
        pg8::EpiDown E{contrib, rowtab}; pg8::gemm_phase<pg8::EpiDown, pg8::MoeSched, false, true>(ldsp, DFF, DFF, DFF, S, E, rowtab); }
    else if (BOTH(8, 9)) xcd_barrier_wait(gbar, tk89);
#else
    if (IN(8)) {
        PH_IDX
        for (long idx = gt; idx < (long)2 * M * DFF; idx += NT) {
            const int pos = (int)(idx / DFF), j = (int)(idx % DFF);
            int e = 0, base = 0;
            for (int q = 0; q < NE; ++q) { const int c = (int)ecnt[64 * q]; if (pos >= base + c) { base += c; e = q + 1; } else break; }
            const int ent = lists[(size_t)e * M + (pos - base)].x; const int tok = ent >> 1;
            const float inv = tok_inv[tok];
            const u32x4* a = (const u32x4*)(h2u + (size_t)tok * D);
            const int np = 256 * (j >> 7) + (j & 127);
            const u32x4* bgp = (const u32x4*)(WguT + ((size_t)e * 1024 + np) * D); const u32x4* bup = (const u32x4*)(WguT + ((size_t)e * 1024 + np + 128) * D);
            float sg = 0.f, su = 0.f;
#pragma unroll 4
            for (int k8 = 0; k8 < D / 8; ++k8) { const u32x4 av = a[k8]; sg += dot8(av, bgp[k8]); su += dot8(av, bup[k8]); }
            sg *= inv; su *= inv;
            act[(size_t)pos * DFF + j] = f2bf(sg * sigmoidf_(sg) * su);
        }
    }
    GRID_BAR(8, 9);
    if (IN(9)) {
        PH_IDX
        for (long idx = gt; idx < (long)2 * M * D; idx += NT) {
            const int pos = (int)(idx / D), n = (int)(idx % D);
            int e = 0, base = 0;
            for (int q = 0; q < NE; ++q) { const int c = (int)ecnt[64 * q]; if (pos >= base + c) { base += c; e = q + 1; } else break; }
            const int ent = lists[(size_t)e * M + (pos - base)].x; const int tok = ent >> 1, kk = ent & 1;
            const u32x4* a = (const u32x4*)(act + (size_t)pos * DFF); const u32x4* b = (const u32x4*)(WdT + ((size_t)e * D + n) * DFF);
            float s = 0.f;
#pragma unroll 4
            for (int k8 = 0; k8 < DFF / 8; ++k8) s += dot8(a[k8], b[k8]);
            contrib[((size_t)kk * M + tok) * D + n] = f2bf(s * tok_w[2 * tok + kk]);
        }
    }
#endif
    GRID_BAR(9, 10);
#if FAST_P10
    if (IN(10)) {
        PH_IDX
        const float* gf = args.in[26]; f32x4 gv[4];
#pragma unroll
        for (int j = 0; j < 4; ++j) gv[j] = *(const f32x4*)(gf + 256 * j + 4 * lane);
        typedef unsigned u32x2_ __attribute__((ext_vector_type(2)));
        u32x2_ xn[4], c0n[4], c1n[4];
#define P10_LOAD(mm) do { _Pragma("unroll") for (int j = 0; j < 4; ++j) { const size_t off = (size_t)(mm) * D + 256 * j + 4 * lane; \
            xn[j] = *(const u32x2_*)(h2u + off); c0n[j] = *(const u32x2_*)(contrib + off); c1n[j] = *(const u32x2_*)(contrib + (size_t)M * D + off); } } while (0)
        if (gw < M) P10_LOAD(gw);
#pragma unroll 1
        for (int m = gw; m < M; m += NW) {
            f32x4 v[4]; float ss = 0.f;
#pragma unroll
            for (int j = 0; j < 4; ++j) v[j] = pg8::bflo4(xn[j].x, xn[j].y) + pg8::bflo4(c0n[j].x, c0n[j].y) + pg8::bflo4(c1n[j].x, c1n[j].y);
            if (m + NW < M) P10_LOAD(m + NW);
#pragma unroll
            for (int j = 0; j < 4; ++j) ss += v[j][0] * v[j][0] + v[j][1] * v[j][1] + v[j][2] * v[j][2] + v[j][3] * v[j][3];
            const float inv = 1.f / sqrtf(wave_sum(ss) * (1.f / D) + EPS);
#pragma unroll
            for (int j = 0; j < 4; ++j) *(f32x4*)(out + (size_t)m * D + 256 * j + 4 * lane) = v[j] * inv * gv[j];
        }
    }
#else
    if (IN(10)) {
        PH_IDX
        const float* gf = args.in[26];
        for (int m = gw; m < M; m += NW) {
            float v[16]; float ss = 0.f;
#pragma unroll
            for (int j = 0; j < 4; ++j)
#pragma unroll
                for (int i = 0; i < 4; ++i) { const int k = 256 * j + 4 * lane + i; const float t = out[(size_t)m * D + k] + bf2f(contrib[(size_t)m * D + k]) + bf2f(contrib[((size_t)M + m) * D + k]); v[4 * j + i] = t; ss += t * t; }
            const float inv = 1.f / sqrtf(wave_sum(ss) * (1.f / D) + EPS);
#pragma unroll
            for (int j = 0; j < 4; ++j)
#pragma unroll
                for (int i = 0; i < 4; ++i) { const int k = 256 * j + 4 * lane + i; out[(size_t)m * D + k] = v[4 * j + i] * inv * gf[k]; }
        }
    }
#endif
#undef IN
}

extern "C" void kernel_launch(void* const* d_in, const int* in_sizes, int n_in, void* d_out, int out_size, void* d_ws, size_t ws_size, hipStream_t stream) {
    static int grid = 0;
    if (grid == 0) {
        if (n_in != 27 || out_size != M * D || ws_size < WS_END) { fprintf(stderr, "kernel_launch: unexpected shapes (n_in %d out %d ws %zu)\n", n_in, out_size, ws_size); grid = -1; return; }
        int dev = 0, cus = 0;
        if (hipGetDevice(&dev) != hipSuccess || hipDeviceGetAttribute(&cus, hipDeviceAttributeMultiprocessorCount, dev) != hipSuccess) { grid = -1; return; }
        if (hipFuncSetAttribute((const void*)fwd, hipFuncAttributeMaxDynamicSharedMemorySize, LDS_BYTES) != hipSuccess) { grid = -1; return; }
        grid = cus;
    }
    if (grid < 0) return;
    (void)hipMemsetAsync((char*)d_ws + WS_CTL, 0, CTL_ZERO_BYTES, stream);
    Args a{};
    for (int i = 0; i < 27; ++i) a.in[i] = (const float*)d_in[i];
    a.out = (float*)d_out; a.ws = (unsigned char*)d_ws;
#if defined(PROBE_PH)
    a.ph_lo = 0; a.ph_hi = PROBE_PH + 1;
    hipLaunchKernelGGL(fwd, dim3(grid), dim3(NTHREADS), LDS_BYTES, stream, a);
    (void)hipMemsetAsync((char*)d_ws + WS_CTL + CW_BAR * 4, 0, XCD_BAR_WORDS * 4, stream);
    (void)hipMemsetAsync((char*)d_ws + WS_CTL + CW_CNT * 4, 0, 2048 * 4, stream);
    a.ph_lo = PROBE_PH; a.ph_hi = NPH;
    hipLaunchKernelGGL(fwd, dim3(grid), dim3(NTHREADS), LDS_BYTES, stream, a);
#elif MK_N_LAUNCHES == 1
    a.ph_lo = 0; a.ph_hi = NPH;
    hipLaunchKernelGGL(fwd, dim3(grid), dim3(NTHREADS), LDS_BYTES, stream, a);
#else
    for (int p = 0; p < NPH; ++p) {
        a.ph_lo = p; a.ph_hi = p + 1;
        hipLaunchKernelGGL(fwd, dim3(grid), dim3(NTHREADS), LDS_BYTES, stream, a);
    }
#endif
}
```
